# Optimizing an MI355X kernel written in HIP

```python
import jax, jax.numpy as jnp
from jax import lax
import numpy as np

D_MODEL = 1024
BATCH = 16
SEQ = 2048
DEPTH = 2

CHUNK = 64
N_META = 16
GLA_HEADS = 4
GLA_KEY = D_MODEL // 2
GLA_VAL = D_MODEL
GLA_DK = GLA_KEY // GLA_HEADS
GLA_DV = GLA_VAL // GLA_HEADS
GATE_RANK = 16
GATE_NORMALIZER = 16.0
POOL_WINDOWS = (2, 4, 8, 16)
POOL_GROUPS = 4
POOL_WIDTH = D_MODEL
POOL_GDIM = POOL_WIDTH // POOL_GROUPS
N_BRANCH = 2
IN_COLS = 2 * GLA_KEY + 2 * GLA_VAL + GATE_RANK + POOL_WIDTH + N_BRANCH * D_MODEL
N_GROUPS = 4
EXPERTS_PER_GROUP = 4
N_EXPERTS = N_GROUPS * EXPERTS_PER_GROUP
TOP_K = 2
D_EXPERT = D_MODEL // 2
EPS = 1e-6

kernel_name = "chunk_causal_gla_pool_hmoe_hybrid"


def rms_norm(x, w):
    xf = x.astype(jnp.float32)
    y = xf * lax.rsqrt(jnp.mean(xf * xf, axis=-1, keepdims=True) + EPS)
    return (y * w.astype(jnp.float32)).astype(x.dtype)


def gla_mixer(q, k, v, og, g_low, w_gate_up, b_gate, norm_w):
    B, L, _ = q.shape
    dt = q.dtype
    pad = (-L) % CHUNK
    n_chunks = (L + pad) // CHUNK
    g = jax.nn.log_sigmoid((g_low @ w_gate_up + b_gate).astype(jnp.float32)) / GATE_NORMALIZER

    def to_chunks(t, hd):
        t = jnp.pad(t, ((0, 0), (pad, 0), (0, 0)))
        return t.reshape(B, n_chunks, CHUNK, GLA_HEADS, hd)

    qc = to_chunks(q * (GLA_DK ** -0.5), GLA_DK)
    kc = to_chunks(k, GLA_DK)
    vc = to_chunks(v, GLA_DV)
    gc = to_chunks(g, GLA_DK)
    b = jnp.cumsum(gc, axis=2)
    gam = b[:, :, -1]
    eb = jnp.exp(b).astype(dt)
    inv_eb = jnp.exp(-b).astype(dt)
    q_eb = qc * eb
    a_lo = jnp.einsum('bnihk,bnjhk->bnhij', q_eb, kc * inv_eb)
    a_up = jnp.einsum('bnihk,bnjhk->bnhij', qc * inv_eb, kc * eb)
    pos = jnp.arange(CHUNK)
    attn = jnp.where(pos[:, None] >= pos[None, :], a_lo, a_up)
    o_intra = jnp.einsum('bnhij,bnjhv->bnihv', attn, vc)
    k_dec = kc * jnp.exp(gam[:, :, None] - b).astype(dt)
    dec = jnp.exp(gam).astype(dt)

    def step(state, inp):
        q_t, k_t, v_t, d_t = inp
        o_t = jnp.einsum('bihk,bhkv->bihv', q_t, state)
        state = d_t[..., None] * state + jnp.einsum('bjhk,bjhv->bhkv', k_t, v_t)
        return state, o_t

    xs = (jnp.moveaxis(q_eb, 1, 0), jnp.moveaxis(k_dec, 1, 0),
          jnp.moveaxis(vc, 1, 0), jnp.moveaxis(dec, 1, 0))
    s0 = jnp.zeros((B, GLA_HEADS, GLA_DK, GLA_DV), dt)
    _, o_inter = lax.scan(step, s0, xs)
    o = o_intra + jnp.moveaxis(o_inter, 0, 1)
    o = rms_norm(o, norm_w)
    o = o.reshape(B, n_chunks * CHUNK, GLA_VAL)[:, pad:]
    return o * jax.nn.silu(og)


def pool_mixer(u, w_grp, scale):
    B, L, _ = u.shape
    uf = u.astype(jnp.float32)
    cs = jnp.concatenate([jnp.zeros((B, 1, POOL_WIDTH), jnp.float32),
                          jnp.cumsum(uf, axis=1)], axis=1)
    t = jnp.arange(L)
    outs = []
    for gi, w in enumerate(POOL_WINDOWS):
        sl = slice(gi * POOL_GDIM, (gi + 1) * POOL_GDIM)
        c = cs[:, :, sl]
        upper = c[:, 1:]
        lower = jnp.pad(c, ((0, 0), (w - 1, 0), (0, 0)))[:, :L]
        count = jnp.minimum(t + 1, w).astype(jnp.float32)[None, :, None]
        outs.append((upper - lower) / count - uf[:, :, sl])
    pooled = jnp.stack(outs, axis=2).astype(u.dtype)
    mixed = jnp.einsum('blgc,gcd->blgd', pooled, w_grp).reshape(B, L, POOL_WIDTH)
    return mixed * scale


def hier_moe(h, w_rg, w_re, w_eg, w_eu, w_ed):
    B, L, D = h.shape
    xt = h.reshape(-1, D)
    T = xt.shape[0]
    pg = jax.nn.softmax((xt @ w_rg).astype(jnp.float32), axis=-1)
    pg_top, g_idx = lax.top_k(pg, 1)
    le = (xt @ w_re).astype(jnp.float32).reshape(T, N_GROUPS, EXPERTS_PER_GROUP)
    le_sel = jnp.take_along_axis(le, g_idx[:, :, None], axis=1)[:, 0]
    pe = jax.nn.softmax(le_sel, axis=-1)
    pe_top, e_idx = lax.top_k(pe, TOP_K)
    wts = pg_top * pe_top / jnp.sum(pe_top, axis=-1, keepdims=True)
    gid = g_idx * EXPERTS_PER_GROUP + e_idx
    comb = jnp.einsum('tk,tke->te', wts,
                      jax.nn.one_hot(gid, N_EXPERTS, dtype=jnp.float32)).astype(h.dtype)
    out = jnp.zeros_like(xt)
    for e in range(N_EXPERTS):
        hid = jax.nn.silu(xt @ w_eg[e]) * (xt @ w_eu[e])
        out = out + comb[:, e:e + 1] * (hid @ w_ed[e])
    return out.reshape(B, L, D)


def setup_inputs(seed: int = 0) -> dict:
    key = jax.random.key(seed)
    ks = jax.random.split(key, 20)
    f32 = jnp.float32

    def nrm(k, shape, scale):
        return jax.random.normal(k, shape, f32) * scale

    return {
        "x": nrm(ks[0], (BATCH, SEQ, D_MODEL), 1.0),
        "meta_tokens": nrm(ks[1], (N_META, D_MODEL), 1.0),
        "norm1_w": 1.0 + nrm(ks[2], (DEPTH, D_MODEL), 0.05),
        "w_in": nrm(ks[3], (DEPTH, D_MODEL, IN_COLS), D_MODEL ** -0.5),
        "w_gate_up": nrm(ks[4], (DEPTH, GATE_RANK, GLA_KEY), GATE_RANK ** -0.5),
        "b_gate": nrm(ks[5], (DEPTH, GLA_KEY), 0.1),
        "gla_norm_w": 1.0 + nrm(ks[6], (DEPTH, GLA_DV), 0.05),
        "w_pool_grp": nrm(ks[7], (DEPTH, POOL_GROUPS, POOL_GDIM, POOL_GDIM), POOL_GDIM ** -0.5),
        "pool_scale": 1.0 + nrm(ks[8], (DEPTH, POOL_WIDTH), 0.1),
        "w_br_gla": nrm(ks[9], (DEPTH, GLA_VAL, D_MODEL), GLA_VAL ** -0.5),
        "w_br_pool": nrm(ks[10], (DEPTH, POOL_WIDTH, D_MODEL), POOL_WIDTH ** -0.5),
        "w_out": nrm(ks[11], (DEPTH, D_MODEL, D_MODEL), D_MODEL ** -0.5),
        "norm2_w": 1.0 + nrm(ks[12], (DEPTH, D_MODEL), 0.05),
        "w_router_group": nrm(ks[13], (DEPTH, D_MODEL, N_GROUPS), D_MODEL ** -0.5),
        "w_router_expert": nrm(ks[14], (DEPTH, D_MODEL, N_EXPERTS), D_MODEL ** -0.5),
        "w_exp_gate": nrm(ks[15], (DEPTH, N_EXPERTS, D_MODEL, D_EXPERT), D_MODEL ** -0.5),
        "w_exp_up": nrm(ks[16], (DEPTH, N_EXPERTS, D_MODEL, D_EXPERT), D_MODEL ** -0.5),
        "w_exp_down": nrm(ks[17], (DEPTH, N_EXPERTS, D_EXPERT, D_MODEL), D_EXPERT ** -0.5),
        "final_norm_w": 1.0 + nrm(ks[18], (D_MODEL,), 0.05),
    }


def reference(x, meta_tokens, norm1_w, w_in, w_gate_up, b_gate, gla_norm_w, w_pool_grp,
              pool_scale, w_br_gla, w_br_pool, w_out, norm2_w, w_router_group,
              w_router_expert, w_exp_gate, w_exp_up, w_exp_down, final_norm_w):
    B = x.shape[0]
    meta = jnp.broadcast_to(meta_tokens[None].astype(x.dtype), (B, N_META, D_MODEL))
    h = jnp.concatenate([meta, x], axis=1)
    splits = [GLA_KEY, 2 * GLA_KEY, 2 * GLA_KEY + GLA_VAL, 2 * GLA_KEY + 2 * GLA_VAL,
              2 * GLA_KEY + 2 * GLA_VAL + GATE_RANK,
              2 * GLA_KEY + 2 * GLA_VAL + GATE_RANK + POOL_WIDTH]
    for l in range(DEPTH):
        hn = rms_norm(h, norm1_w[l])
        z = hn @ w_in[l]
        q, k, v, og, g_low, u, gate_cols = jnp.split(z, splits, axis=-1)
        y_gla = gla_mixer(q, k, v, og, g_low, w_gate_up[l], b_gate[l], gla_norm_w[l])
        y_pool = pool_mixer(u, w_pool_grp[l], pool_scale[l])
        gates = jax.nn.sigmoid(gate_cols.reshape(B, -1, N_BRANCH, D_MODEL))
        merged = (gates[:, :, 0] * (y_gla @ w_br_gla[l])
                  + gates[:, :, 1] * (y_pool @ w_br_pool[l]))
        h = h + merged @ w_out[l]
        h = h + hier_moe(rms_norm(h, norm2_w[l]), w_router_group[l], w_router_expert[l],
                         w_exp_gate[l], w_exp_up[l], w_exp_down[l])
    h = rms_norm(h, final_norm_w)
    return h[:, N_META:]
```

```cpp
#include <hip/hip_runtime.h>
#include <stdint.h>
#include <stdio.h>

typedef unsigned short bf16_t;
typedef short bf16x8 __attribute__((ext_vector_type(8)));
typedef float f32x4 __attribute__((ext_vector_type(4)));
typedef unsigned u32x4 __attribute__((ext_vector_type(4)));
typedef unsigned u32x2 __attribute__((ext_vector_type(2)));
#define LAS __attribute__((address_space(3)))

constexpr int DM = 1024, NB = 16, SEQ = 2048, NMETA = 16, LSEQ = SEQ + NMETA, T = NB * LSEQ;
constexpr int SEG0_LEN = 1040, SEG1_LEN = 1024, SEG0_ROWS = NB * SEG0_LEN, SEG1_ROWS = NB * SEG1_LEN;
constexpr int ZC = 6656;
constexpr int ZQ = 0, ZK = 512, ZV = 1024, ZOG = 2048, ZG = 3072, ZU = 3584, ZG0 = 4608, ZG1 = 5632;
constexpr int IN_COLS = 6160;
constexpr int NCLS = 24, MAXCT = 160;
constexpr float EPS = 1e-6f;

constexpr size_t WS_CTL = 0;
constexpr size_t CTL_BYTES = 65536;
constexpr size_t WS_H = WS_CTL + CTL_BYTES;
constexpr size_t WS_HB = WS_H + (size_t)T * DM * 4;
constexpr size_t WS_SS = WS_HB + (size_t)T * DM * 2;
constexpr size_t WS_Z = WS_SS + (size_t)T * 4;
constexpr size_t Z_BYTES = (size_t)SEG0_ROWS * ZC * 2;
constexpr size_t WS_W0 = WS_Z + Z_BYTES;
constexpr size_t W_IN = 0, W_GRP = W_IN + (size_t)ZC * DM * 2, W_BRG = W_GRP + 4 * 256 * 256 * 2, W_BRP = W_BRG + (size_t)DM * DM * 2, W_OUT = W_BRP + (size_t)DM * DM * 2,
                 W_GU = W_OUT + (size_t)DM * DM * 2, W_DN = W_GU + (size_t)16 * 1024 * 1024 * 2, W_BYTES = W_DN + (size_t)16 * 1024 * 512 * 2;
constexpr size_t WS_STATE = WS_W0 + W_BYTES;
constexpr size_t WS_HALO = WS_STATE + (size_t)256 * 8192 * 4;
constexpr size_t WS_END = WS_HALO + (size_t)16 * 15 * 1024 * 2;
constexpr size_t MZ_XN = 0;
constexpr size_t MZ_HID = MZ_XN + (size_t)T * DM * 2;
constexpr size_t MZ_LIST = MZ_HID + (size_t)MAXCT * 256 * 1024 * 2;
constexpr size_t MZ_WTS = MZ_LIST + (size_t)NCLS * T * 4;
constexpr size_t MZ_END = MZ_WTS + (size_t)NCLS * T * 8;
static_assert(MZ_END <= Z_BYTES, "MoE buffers must fit the z region");
static_assert(WS_END <= (size_t)536870912, "workspace");
static_assert(W_BYTES <= (size_t)NB * SEQ * DM * 4, "layer-1 weights must fit d_out");
constexpr int CW_BAR = 0;
constexpr int CW_CNT = 4096;
constexpr int CW_TICKET = 8192;

constexpr int LDS_BYTES = 160 * 1024;
constexpr int MISC_OFF = LDS_BYTES - 256;

__device__ __forceinline__ float bf2f(bf16_t v) { return __uint_as_float(((unsigned)v) << 16); }
__device__ __forceinline__ bf16_t f2bf(float f) { unsigned u = __float_as_uint(f); u += 0x7FFFu + ((u >> 16) & 1u); return (bf16_t)(u >> 16); }
__device__ __forceinline__ unsigned pk2(float lo, float hi) { return (unsigned)f2bf(lo) | ((unsigned)f2bf(hi) << 16); }
__device__ __forceinline__ float sigmoidf_(float x) { return 1.0f / (1.0f + __expf(-x)); }
__device__ __forceinline__ float siluf_(float x) { return x / (1.0f + __expf(-x)); }
__device__ __forceinline__ float logsigmoidf_(float x) { return fminf(x, 0.f) - log1pf(__expf(-fabsf(x))); }
__device__ __forceinline__ float wave_sum(float v) { for (int o = 32; o >= 1; o >>= 1) v += __shfl_xor(v, o); return v; }
__device__ __forceinline__ int row_of(int b, int p) { return p < SEG0_LEN ? b * SEG0_LEN + p : SEG0_ROWS + b * SEG1_LEN + (p - SEG0_LEN); }
__device__ __forceinline__ void bp_of(int row, int& b, int& p) { if (row < SEG0_ROWS) { b = row / SEG0_LEN; p = row - b * SEG0_LEN; } else { const int r = row - SEG0_ROWS; b = r >> 10; p = SEG0_LEN + (r & 1023); } }
#define XB_TMO      128
#define XB_XCNT(j)  (256  + 64 * (j))
#define XB_XSUB(j)  (1280 + 64 * (j))
#define XB_XGEN(j)  (2304 + 64 * (j))
#define XB_TOP      3328
#define XB_TOPGEN   3392
#define XCD_BAR_WORDS 3456
#define XB_SPIN_CAP (1u << 18)
#define LAS __attribute__((address_space(3)))

__device__ __forceinline__ unsigned xb_ld(unsigned* p)              { return __hip_atomic_load(p, __ATOMIC_RELAXED, __HIP_MEMORY_SCOPE_AGENT); }
__device__ __forceinline__ unsigned xb_add(unsigned* p, unsigned v) { return __hip_atomic_fetch_add(p, v, __ATOMIC_RELAXED, __HIP_MEMORY_SCOPE_AGENT); }
__device__ __forceinline__ unsigned xb_xcc_id() { return (unsigned)__builtin_amdgcn_s_getreg((3 << 11) | 20) & 0xFu; }
#define XB_SPIN(cond, bar) do { unsigned _sp = 0; while (cond) { __builtin_amdgcn_s_sleep(1); \
    if ((++_sp & 255u) == 0u) { if (xb_ld(&(bar)[XB_TMO])) break; if (_sp > XB_SPIN_CAP) { atomicAdd(&(bar)[XB_TMO], 1u); break; } } } } while (0)

struct XcdBarrier {
    unsigned* bar; unsigned x;
    volatile LAS unsigned* st;
};

__device__ __forceinline__ XcdBarrier xcd_barrier_post(unsigned* bar, volatile LAS unsigned* st) {
    XcdBarrier b; b.bar = bar; b.x = xb_xcc_id(); b.st = st;
    if (threadIdx.x == 0) (void)xb_add(&bar[XB_XCNT(b.x)], 1u);
    return b;
}
__device__ __forceinline__ void xcd_barrier_complete(unsigned* bar, unsigned x, unsigned& nloc, unsigned& nx) {
    const unsigned G = gridDim.x * gridDim.y * gridDim.z;
    unsigned sum, cnt, mine, sp = 0u;
    for (;;) {
        sum = 0u; cnt = 0u; mine = 0u;
#pragma unroll
        for (unsigned j = 0; j < 16; ++j) { const unsigned c = xb_ld(&bar[XB_XCNT(j)]); sum += c; cnt += (c > 0u) ? 1u : 0u; mine = (j == x) ? c : mine; }
        if (sum == G) break;
        __builtin_amdgcn_s_sleep(1);
        if ((++sp & 255u) == 0u) { if (xb_ld(&bar[XB_TMO])) break; if (sp > XB_SPIN_CAP) { atomicAdd(&bar[XB_TMO], 1u); break; } }
    }
    nloc = mine > 0u ? mine : 1u; nx = cnt > 0u ? cnt : 1u;
}

__device__ __forceinline__ void xcd_barrier(const XcdBarrier& b) {
    asm volatile("s_waitcnt vmcnt(0)" ::: "memory");
    __syncthreads();
    if (threadIdx.x == 0) {
        unsigned* bar = b.bar;
        __builtin_amdgcn_s_waitcnt(0);
        unsigned nloc = b.st[0], nx = b.st[1];
        if (nloc == 0u) { xcd_barrier_complete(bar, b.x, nloc, nx); b.st[0] = nloc; b.st[1] = nx; }
        const unsigned old = xb_add(&bar[XB_XSUB(b.x)], 1u);
        const unsigned gen = old / nloc;
        if (old + 1u == (gen + 1u) * nloc) {
            __builtin_amdgcn_fence(__ATOMIC_RELEASE, "agent");
            asm volatile("s_waitcnt vmcnt(0)" ::: "memory");
            const unsigned og = xb_add(&bar[XB_TOP], 1u);
            const unsigned tg = og / nx;
            if (og + 1u == (tg + 1u) * nx) xb_add(&bar[XB_TOPGEN], 1u);
            else XB_SPIN(xb_ld(&bar[XB_TOPGEN]) == tg, bar);
            __builtin_amdgcn_fence(__ATOMIC_ACQUIRE, "agent");
            xb_add(&bar[XB_XGEN(b.x)], 1u);
            asm volatile("s_waitcnt vmcnt(0)" ::: "memory");
        } else {
            XB_SPIN(xb_ld(&bar[XB_XGEN(b.x)]) == gen, bar);
            __builtin_amdgcn_fence(__ATOMIC_ACQUIRE, "agent");
            asm volatile("s_waitcnt vmcnt(0)" ::: "memory");
        }
    }
    __syncthreads();
}
struct Ctx {
    const float* in[19]; float* out; unsigned char* ws;
    LAS unsigned char* lds; int tid, lane, wave, G, wg;
    unsigned* ctl; float* H; bf16_t* HB; float* SS; bf16_t* Z;
};
struct LayerW {
    const bf16_t *Bin, *Bgrp, *Bbrg, *Bbrp, *Bout, *Bgu, *Bdn;
    const float *b_gate, *gla_nw, *pool_scale, *norm2_w, *w_rg, *w_re;
};
__device__ __forceinline__ LayerW layer_w(const Ctx& c, int l) {
    LayerW w; const unsigned char* base = (l == 0) ? (c.ws + WS_W0) : (const unsigned char*)c.out;
    w.Bin = (const bf16_t*)(base + W_IN); w.Bgrp = (const bf16_t*)(base + W_GRP); w.Bbrg = (const bf16_t*)(base + W_BRG); w.Bbrp = (const bf16_t*)(base + W_BRP);
    w.Bout = (const bf16_t*)(base + W_OUT); w.Bgu = (const bf16_t*)(base + W_GU); w.Bdn = (const bf16_t*)(base + W_DN);
    w.b_gate = c.in[5] + l * 512; w.gla_nw = c.in[6] + l * 256; w.pool_scale = c.in[8] + l * 1024; w.norm2_w = c.in[12] + l * 1024;
    w.w_rg = c.in[13] + (size_t)l * 1024 * 4; w.w_re = c.in[14] + (size_t)l * 1024 * 16;
    return w;
}

struct CvtItem { const float* src; int ldS, k0, n0; bf16_t* dst; int ldD, drow0; const float* rs; float cs; };
constexpr int CVT_A = 96 * 16, CVT_B = 64, CVT_C = 768, CVT_D = 4096, CVT_E = 2048, CVT_PER_LAYER = CVT_A + CVT_B + CVT_C + CVT_D + CVT_E;
__device__ __forceinline__ void cvt_decode(const Ctx& c, int l, int idx, CvtItem& it) {
    const uintptr_t i9 = (uintptr_t)c.in[9], i10 = (uintptr_t)c.in[10], i11 = (uintptr_t)c.in[11], i15 = (uintptr_t)c.in[15], i16 = (uintptr_t)c.in[16];
    unsigned char* base = (l == 0) ? (c.ws + WS_W0) : (unsigned char*)c.out;
    it.rs = nullptr; it.cs = 1.0f;
    if (idx < CVT_A) { const int nb = idx >> 4, kb = idx & 15;
        it.src = c.in[3] + (size_t)l * DM * IN_COLS; it.ldS = IN_COLS; it.k0 = kb * 64; it.dst = (bf16_t*)(base + W_IN); it.ldD = DM; it.rs = c.in[2] + l * DM;
        if (nb < 48) { it.n0 = nb * 64; it.drow0 = nb * 64; if (nb < 8) it.cs = 0.08838834764831845f; }
        else { it.n0 = 3088 + (nb - 48) * 64; it.drow0 = ZU + (nb - 48) * 64; }
        return; }
    idx -= CVT_A;
    if (idx < CVT_B) { const int g = idx >> 4, r = idx & 15, nb = r >> 2, kb = r & 3;
        it.src = c.in[7] + (size_t)l * 4 * 65536 + (size_t)g * 65536; it.ldS = 256; it.k0 = kb * 64; it.n0 = nb * 64; it.dst = (bf16_t*)(base + W_GRP) + (size_t)g * 65536; it.ldD = 256; it.drow0 = nb * 64; return; }
    idx -= CVT_B;
    if (idx < CVT_C) { const int m = idx >> 8, r = idx & 255, nb = r >> 4, kb = r & 15;
        it.src = (const float*)(m == 0 ? i9 : (m == 1 ? i10 : i11)) + (size_t)l * DM * DM; it.ldS = DM; it.k0 = kb * 64; it.n0 = nb * 64;
        it.dst = (bf16_t*)(base + (m == 0 ? W_BRG : (m == 1 ? W_BRP : W_OUT))); it.ldD = DM; it.drow0 = nb * 64; return; }
    idx -= CVT_C;
    if (idx < CVT_D) { const int e = idx >> 8, r = idx & 255, rb = r >> 4, kb = r & 15, j = rb >> 2, sub = rb & 3;
        const float* s = (const float*)((sub < 2) ? i15 : i16);
        it.src = s + ((size_t)l * 16 + e) * 1024 * 512; it.ldS = 512; it.k0 = kb * 64; it.n0 = 128 * j + 64 * (sub & 1);
        it.dst = (bf16_t*)(base + W_GU) + (size_t)e * 1024 * 1024; it.ldD = 1024; it.drow0 = rb * 64; return; }
    idx -= CVT_D;
    { const int e = idx >> 7, r = idx & 127, nb = r >> 3, kb = r & 7;
        it.src = c.in[17] + ((size_t)l * 16 + e) * 512 * 1024; it.ldS = 1024; it.k0 = kb * 64; it.n0 = nb * 64;
        it.dst = (bf16_t*)(base + W_DN) + (size_t)e * 1024 * 512; it.ldD = 512; it.drow0 = nb * 64; }
}
__device__ __forceinline__ void phase_prep(const Ctx& c) {
    for (int row = c.wg * 8 + c.wave; row < T; row += c.G * 8) {
        int b, p; bp_of(row, b, p);
        const float* src = (p < NMETA) ? (c.in[1] + (size_t)p * DM) : (c.in[0] + ((size_t)b * SEQ + (p - NMETA)) * DM);
        float ss = 0.f;
#pragma unroll
        for (int i = 0; i < 4; ++i) { const int col = c.lane * 4 + 256 * i; const f32x4 v = *(const f32x4*)(src + col);
            ss += v[0] * v[0] + v[1] * v[1] + v[2] * v[2] + v[3] * v[3];
            *(f32x4*)(c.H + (size_t)row * DM + col) = v;
            u32x2 w; w.x = pk2(v[0], v[1]); w.y = pk2(v[2], v[3]); *(u32x2*)(c.HB + (size_t)row * DM + col) = w; }
        ss = wave_sum(ss);
        if (c.lane == 0) c.SS[row] = ss;
    }
    LAS float* tile = (LAS float*)c.lds;
    for (int idx = c.wg; idx < 2 * CVT_PER_LAYER; idx += c.G) {
        const int l = idx / CVT_PER_LAYER; CvtItem it; cvt_decode(c, l, idx - l * CVT_PER_LAYER, it);
        __syncthreads();
#pragma unroll
        for (int i = 0; i < 8; ++i) { const int e = c.tid + 512 * i, kk = e >> 6, nn = e & 63;
            float v = it.src[(size_t)(it.k0 + kk) * it.ldS + it.n0 + nn] * it.cs; if (it.rs) v *= it.rs[it.k0 + kk];
            tile[kk * 65 + nn] = v; }
        __syncthreads();
#pragma unroll
        for (int i = 0; i < 4; ++i) { const int e = c.tid + 512 * i, nn = e >> 5, kp = e & 31;
            *(unsigned*)(it.dst + (size_t)(it.drow0 + nn) * it.ldD + it.k0 + 2 * kp) = pk2(tile[(2 * kp) * 65 + nn], tile[(2 * kp + 1) * 65 + nn]); }
    }
    __syncthreads();
    for (int idx = c.wg * 512 + c.tid; idx < 2 * 512 * 1024; idx += c.G * 512) {
        const int l = idx >> 19, j = (idx >> 10) & 511, k = idx & 1023;
        const float* wi = c.in[3] + (size_t)l * DM * IN_COLS + (size_t)k * IN_COLS + 3072; const float* wu = c.in[4] + (size_t)l * 16 * 512 + j;
        float a = 0.f;
#pragma unroll
        for (int r = 0; r < 16; ++r) a += wi[r] * wu[r * 512];
        unsigned char* base = (l == 0) ? (c.ws + WS_W0) : (unsigned char*)c.out;
        ((bf16_t*)(base + W_IN))[(size_t)(ZG + j) * DM + k] = f2bf(a * c.in[2][l * DM + k]);
    }
}

__device__ __forceinline__ void sg_acc(f32x4 (&acc)[4], const bf16_t* arow, const bf16_t* B, int ldb, int brow0, int K, int lane) {
    const bf16_t* ap = arow + 8 * (lane >> 4);
    const bf16_t* bp = B + (size_t)(brow0 + (lane & 15)) * ldb + 8 * (lane >> 4);
    for (int k0 = 0; k0 < K; k0 += 32) {
        const bf16x8 a = *(const bf16x8*)(ap + k0);
#pragma unroll
        for (int j = 0; j < 4; ++j) { const bf16x8 b = *(const bf16x8*)(bp + (size_t)(16 * j) * ldb + k0); acc[j] = __builtin_amdgcn_mfma_f32_16x16x32_bf16(a, b, acc[j], 0, 0, 0); }
    }
}
#define ZERO_ACC(acc) do { _Pragma("unroll") for (int _j = 0; _j < 4; ++_j) acc[_j] = (f32x4){0.f, 0.f, 0.f, 0.f}; } while (0)

__device__ __forceinline__ float p1_act(float v, int col, const float* b_gate) {
    if (col < ZOG) return v;
    if (col < ZG) return siluf_(v);
    if (col < ZU) return logsigmoidf_(v + b_gate[col - ZG]) * 0.0625f;
    if (col < ZG0) return v;
    return sigmoidf_(v);
}

__device__ __forceinline__ void p1_simple(const Ctx& c, const LayerW& w, int segbase, int segrows) {
    const int ntn = ZC / 64, ntiles = (segrows / 16) * ntn;
    for (int t = c.wg * 8 + c.wave; t < ntiles; t += c.G * 8) {
        const int m0 = (t / ntn) * 16, n0 = (t % ntn) * 64;
        f32x4 acc[4]; ZERO_ACC(acc);
        sg_acc(acc, c.HB + (size_t)(segbase + m0 + (c.lane & 15)) * DM, w.Bin, DM, n0, DM, c.lane);
#pragma unroll
        for (int r = 0; r < 4; ++r) { const int m = m0 + (c.lane >> 4) * 4 + r; const float rstd = rsqrtf(c.SS[segbase + m] * (1.0f / DM) + EPS);
#pragma unroll
            for (int j = 0; j < 4; ++j) { const int col = n0 + 16 * j + (c.lane & 15); c.Z[(size_t)m * ZC + col] = f2bf(p1_act(acc[j][r] * rstd, col, w.b_gate)); } }
    }
}

__device__ __forceinline__ void gla_simple(const Ctx& c, int seg) {
    constexpr int ST = 130;
    LAS bf16_t* QE = (LAS bf16_t*)c.lds; LAS bf16_t* QI = QE + 64 * ST; LAS bf16_t* KE = QI + 64 * ST; LAS bf16_t* KI = KE + 64 * ST; LAS bf16_t* KD = KI + 64 * ST;
    LAS float* V = (LAS float*)(c.lds + 5 * 64 * ST * 2);
    LAS float* ATT = V + 4096;
    LAS float* S = ATT + 4096;
    LAS float* EG = S + 8192;
    float* stsave = (float*)(c.ws + WS_STATE);
    for (int chain = c.wg; chain < 256; chain += c.G) {
        const int b = chain >> 4, h = (chain >> 2) & 3, s = chain & 3;
        __syncthreads();
        for (int e = c.tid; e < 8192; e += 512) S[e] = (seg == 0) ? 0.f : stsave[(size_t)chain * 8192 + e];
        const int c_lo = seg == 0 ? 0 : 17, c_hi = seg == 0 ? 17 : 33;
        for (int ch = c_lo; ch < c_hi; ++ch) {
            int r0, nvalid;
            if (seg == 0) { if (ch == 0) { r0 = b * SEG0_LEN; nvalid = 16; } else { r0 = b * SEG0_LEN + 16 + 64 * (ch - 1); nvalid = 64; } }
            else { r0 = b * SEG1_LEN + 64 * (ch - 17); nvalid = 64; }
            const bf16_t* zr = c.Z + (size_t)r0 * ZC;
            __syncthreads();
            if (c.tid < 128) { const int ci = c.tid; float bb = 0.f;
                for (int i = 0; i < 64; ++i) { float q = 0.f, k = 0.f, g = 0.f;
                    if (i < nvalid) { const bf16_t* rp = zr + (size_t)i * ZC + h * 128 + ci; q = bf2f(rp[ZQ]); k = bf2f(rp[ZK]); g = bf2f(rp[ZG]); }
                    bb += g; const float e = __expf(bb), ie = __expf(-bb);
                    QE[i * ST + ci] = f2bf(q * e); QI[i * ST + ci] = f2bf(q * ie); KE[i * ST + ci] = f2bf(k * e); KI[i * ST + ci] = f2bf(k * ie); }
                const float gam = bb; EG[ci] = __expf(gam); bb = 0.f;
                for (int i = 0; i < 64; ++i) { float k = 0.f, g = 0.f;
                    if (i < nvalid) { const bf16_t* rp = zr + (size_t)i * ZC + h * 128 + ci; k = bf2f(rp[ZK]); g = bf2f(rp[ZG]); }
                    bb += g; KD[i * ST + ci] = f2bf(k * __expf(gam - bb)); } }
            for (int e = c.tid; e < 4096; e += 512) { const int i = e >> 6, vv = e & 63; V[e] = (i < nvalid) ? bf2f(zr[(size_t)i * ZC + ZV + h * 256 + s * 64 + vv]) : 0.f; }
            __syncthreads();
            for (int e = c.tid; e < 4096; e += 512) { const int i = e >> 6, j = e & 63; float a = 0.f;
                if (i >= j) { for (int k = 0; k < 128; ++k) a += bf2f(QE[i * ST + k]) * bf2f(KI[j * ST + k]); }
                else { for (int k = 0; k < 128; ++k) a += bf2f(QI[i * ST + k]) * bf2f(KE[j * ST + k]); }
                ATT[e] = bf2f(f2bf(a)); }
            __syncthreads();
            for (int e = c.tid; e < 4096; e += 512) { const int i = e >> 6, vv = e & 63; float o = 0.f;
                for (int j = 0; j < 64; ++j) o += ATT[i * 64 + j] * V[j * 64 + vv];
                for (int k = 0; k < 128; ++k) o += bf2f(QE[i * ST + k]) * bf2f(f2bf(S[k * 64 + vv]));
                if (i < nvalid) c.Z[(size_t)(r0 + i) * ZC + ZV + h * 256 + s * 64 + vv] = f2bf(o); }
            __syncthreads();
            for (int e = c.tid; e < 8192; e += 512) { const int k = e >> 6, vv = e & 63; float a = EG[k] * S[e];
                for (int j = 0; j < 64; ++j) a += bf2f(KD[j * ST + k]) * V[j * 64 + vv];
                S[e] = a; }
        }
        __syncthreads();
        if (seg == 0) for (int e = c.tid; e < 8192; e += 512) stsave[(size_t)chain * 8192 + e] = S[e];
    }
}

__device__ __forceinline__ void pool_phase(const Ctx& c, int seg) {
    const int segbase = seg ? SEG0_ROWS : 0, segrows = seg ? SEG1_ROWS : SEG0_ROWS, seglen = seg ? SEG1_LEN : SEG0_LEN;
    bf16_t* halo = (bf16_t*)(c.ws + WS_HALO);
    const int nitem = segrows * 128;
    for (int it = c.wg * 512 + c.tid; it < nitem; it += c.G * 512) {
        const int r = it >> 7, cc = (it & 127) * 8, b = r / seglen, pl = r - b * seglen, p = seg ? SEG0_LEN + pl : pl;
        const int w = 2 << (cc >> 8);
        const int cnt = (p + 1 < w) ? p + 1 : w;
        float s[8];
#pragma unroll
        for (int j = 0; j < 8; ++j) s[j] = 0.f;
        u32x4 self = (u32x4){0u, 0u, 0u, 0u};
        for (int i = 0; i < cnt; ++i) {
            u32x4 v;
            if (pl - i >= 0) v = *(const u32x4*)(c.Z + (size_t)(r - i) * ZC + ZU + cc);
            else v = *(const u32x4*)(halo + ((size_t)b * 15 + (15 + pl - i)) * 1024 + cc);
            if (i == 0) self = v;
#pragma unroll
            for (int j = 0; j < 4; ++j) { s[2 * j] += __uint_as_float(v[j] << 16); s[2 * j + 1] += __uint_as_float(v[j] & 0xffff0000u); }
        }
        const float inv = 1.0f / (float)cnt; u32x4 o;
#pragma unroll
        for (int j = 0; j < 4; ++j) o[j] = pk2(s[2 * j] * inv - __uint_as_float(self[j] << 16), s[2 * j + 1] * inv - __uint_as_float(self[j] & 0xffff0000u));
        *(u32x4*)(c.HB + (size_t)(segbase + r) * DM + cc) = o;
        if (seg == 0 && pl >= SEG0_LEN - 15) *(u32x4*)(halo + ((size_t)b * 15 + (pl - (SEG0_LEN - 15))) * 1024 + cc) = self;
    }
}

__device__ __forceinline__ void ygla_phase(const Ctx& c, const LayerW& w, int segrows) {
    for (int r = c.wg * 8 + c.wave; r < segrows; r += c.G * 8) {
        bf16_t* zr = c.Z + (size_t)r * ZC; const int col = c.lane * 16;
        const u32x4 o0 = *(const u32x4*)(zr + ZV + col), o1 = *(const u32x4*)(zr + ZV + col + 8);
        const u32x4 g0 = *(const u32x4*)(zr + ZOG + col), g1 = *(const u32x4*)(zr + ZOG + col + 8);
        float o[16], sg[16];
#pragma unroll
        for (int j = 0; j < 4; ++j) { o[2 * j] = __uint_as_float(o0[j] << 16); o[2 * j + 1] = __uint_as_float(o0[j] & 0xffff0000u); o[8 + 2 * j] = __uint_as_float(o1[j] << 16); o[8 + 2 * j + 1] = __uint_as_float(o1[j] & 0xffff0000u);
            sg[2 * j] = __uint_as_float(g0[j] << 16); sg[2 * j + 1] = __uint_as_float(g0[j] & 0xffff0000u); sg[8 + 2 * j] = __uint_as_float(g1[j] << 16); sg[8 + 2 * j + 1] = __uint_as_float(g1[j] & 0xffff0000u); }
        float ss = 0.f;
#pragma unroll
        for (int j = 0; j < 16; ++j) ss += o[j] * o[j];
        ss += __shfl_xor(ss, 1); ss += __shfl_xor(ss, 2); ss += __shfl_xor(ss, 4); ss += __shfl_xor(ss, 8);
        const float rs = rsqrtf(ss * (1.0f / 256.0f) + EPS);
        const float* nw = w.gla_nw + (col & 255);
        u32x4 y0, y1;
#pragma unroll
        for (int j = 0; j < 4; ++j) { y0[j] = pk2(o[2 * j] * rs * nw[2 * j] * sg[2 * j], o[2 * j + 1] * rs * nw[2 * j + 1] * sg[2 * j + 1]);
            y1[j] = pk2(o[8 + 2 * j] * rs * nw[8 + 2 * j] * sg[8 + 2 * j], o[8 + 2 * j + 1] * rs * nw[8 + 2 * j + 1] * sg[8 + 2 * j + 1]); }
        *(u32x4*)(zr + ZOG + col) = y0; *(u32x4*)(zr + ZOG + col + 8) = y1;
    }
}
__device__ __forceinline__ void p3_simple(const Ctx& c, const LayerW& w, int segbase, int segrows) {
    const int ntiles = (segrows / 16) * 16;
    for (int t = c.wg * 8 + c.wave; t < ntiles; t += c.G * 8) {
        const int m0 = (t >> 4) * 16, n0 = (t & 15) * 64, g = n0 >> 8;
        f32x4 acc[4]; ZERO_ACC(acc);
        sg_acc(acc, c.HB + (size_t)(segbase + m0 + (c.lane & 15)) * DM + 256 * g, w.Bgrp + (size_t)g * 65536, 256, n0 & 255, 256, c.lane);
#pragma unroll
        for (int r = 0; r < 4; ++r) { const int m = m0 + (c.lane >> 4) * 4 + r;
#pragma unroll
            for (int j = 0; j < 4; ++j) { const int col = n0 + 16 * j + (c.lane & 15); c.Z[(size_t)m * ZC + ZQ + col] = f2bf(acc[j][r] * w.pool_scale[col]); } }
    }
}
__device__ __forceinline__ void p4_simple(const Ctx& c, const LayerW& w, int segrows) {
    const int ntiles = (segrows / 16) * 16;
    for (int t = c.wg * 8 + c.wave; t < ntiles; t += c.G * 8) {
        const int m0 = (t >> 4) * 16, n0 = (t & 15) * 64;
        f32x4 a1[4], a2[4]; ZERO_ACC(a1); ZERO_ACC(a2);
        sg_acc(a1, c.Z + (size_t)(m0 + (c.lane & 15)) * ZC + ZOG, w.Bbrg, DM, n0, DM, c.lane);
        sg_acc(a2, c.Z + (size_t)(m0 + (c.lane & 15)) * ZC + ZQ, w.Bbrp, DM, n0, DM, c.lane);
#pragma unroll
        for (int r = 0; r < 4; ++r) { const int m = m0 + (c.lane >> 4) * 4 + r; bf16_t* zr = c.Z + (size_t)m * ZC;
#pragma unroll
            for (int j = 0; j < 4; ++j) { const int col = n0 + 16 * j + (c.lane & 15); zr[ZV + col] = f2bf(bf2f(zr[ZG0 + col]) * a1[j][r] + bf2f(zr[ZG1 + col]) * a2[j][r]); } }
    }
}
__device__ __forceinline__ void p5_simple(const Ctx& c, const LayerW& w, int segbase, int segrows) {
    const int ntiles = (segrows / 16) * 16;
    for (int t = c.wg * 8 + c.wave; t < ntiles; t += c.G * 8) {
        const int m0 = (t >> 4) * 16, n0 = (t & 15) * 64;
        f32x4 acc[4]; ZERO_ACC(acc);
        sg_acc(acc, c.Z + (size_t)(m0 + (c.lane & 15)) * ZC + ZV, w.Bout, DM, n0, DM, c.lane);
#pragma unroll
        for (int r = 0; r < 4; ++r) { const int m = segbase + m0 + (c.lane >> 4) * 4 + r;
#pragma unroll
            for (int j = 0; j < 4; ++j) { const int col = n0 + 16 * j + (c.lane & 15); c.H[(size_t)m * DM + col] += acc[j][r]; } }
    }
}

__device__ __forceinline__ void route_phase(const Ctx& c, const LayerW& w, int layer) {
    LAS float* WR = (LAS float*)c.lds;
    for (int e = c.tid; e < 20 * 1024; e += 512) { const int j = e >> 10, k = e & 1023; WR[e] = (j < 4) ? w.w_rg[k * 4 + j] : w.w_re[k * 16 + (j - 4)]; }
    __syncthreads();
    bf16_t* XN = (bf16_t*)((unsigned char*)c.Z + MZ_XN); int* LIST = (int*)((unsigned char*)c.Z + MZ_LIST); float* WTS = (float*)((unsigned char*)c.Z + MZ_WTS);
    unsigned* cnt = c.ctl + CW_CNT + layer * 32;
    for (int row = c.wg * 8 + c.wave; row < T; row += c.G * 8) {
        const float* hr = c.H + (size_t)row * DM; float x[16]; float ss = 0.f;
#pragma unroll
        for (int i = 0; i < 4; ++i) { const f32x4 v = *(const f32x4*)(hr + c.lane * 4 + 256 * i); x[4 * i] = v[0]; x[4 * i + 1] = v[1]; x[4 * i + 2] = v[2]; x[4 * i + 3] = v[3]; ss += v[0] * v[0] + v[1] * v[1] + v[2] * v[2] + v[3] * v[3]; }
        ss = wave_sum(ss);
        const float rstd = rsqrtf(ss * (1.0f / DM) + EPS);
#pragma unroll
        for (int i = 0; i < 4; ++i) { const f32x4 nw = *(const f32x4*)(w.norm2_w + c.lane * 4 + 256 * i);
#pragma unroll
            for (int j = 0; j < 4; ++j) x[4 * i + j] = x[4 * i + j] * rstd * nw[j];
            u32x2 pk; pk.x = pk2(x[4 * i], x[4 * i + 1]); pk.y = pk2(x[4 * i + 2], x[4 * i + 3]); *(u32x2*)(XN + (size_t)row * DM + c.lane * 4 + 256 * i) = pk; }
        float mylg = 0.f;
#pragma unroll 1
        for (int j = 0; j < 20; ++j) { float a = 0.f;
#pragma unroll
            for (int i = 0; i < 4; ++i) { const f32x4 wv = *(const LAS f32x4*)(WR + j * 1024 + c.lane * 4 + 256 * i); a += x[4 * i] * wv[0] + x[4 * i + 1] * wv[1] + x[4 * i + 2] * wv[2] + x[4 * i + 3] * wv[3]; }
            a = wave_sum(a); mylg = (c.lane == j) ? a : mylg; }
        float lg[20];
#pragma unroll
        for (int j = 0; j < 20; ++j) lg[j] = __shfl(mylg, j);
        if (c.lane == 0) {
            int g = 0; float gm = lg[0];
#pragma unroll
            for (int j = 1; j < 4; ++j) if (lg[j] > gm) { gm = lg[j]; g = j; }
            float den = 0.f;
#pragma unroll
            for (int j = 0; j < 4; ++j) den += __expf(lg[j] - gm);
            const float pg = 1.0f / den;
            float le[4];
#pragma unroll
            for (int j = 0; j < 4; ++j) le[j] = (g == 0) ? +lg[4 + j] : (g == 1) ? +lg[8 + j] : (g == 2) ? +lg[12 + j] : +lg[16 + j];
            int i1 = 0; float m1 = le[0];
#pragma unroll
            for (int j = 1; j < 4; ++j) if (le[j] > m1) { m1 = le[j]; i1 = j; }
            int i2 = -1; float m2 = -3.0e38f;
#pragma unroll
            for (int j = 0; j < 4; ++j) if (j != i1 && le[j] > m2) { m2 = le[j]; i2 = j; }
            const float w1 = pg / (1.0f + __expf(m2 - m1)), w2 = pg - w1;
            const int a = i1 < i2 ? +i1 : +i2, bq = i1 < i2 ? +i2 : +i1; const float wa = i1 < i2 ? +w1 : +w2, wb = i1 < i2 ? +w2 : +w1;
            const int pidx = (a == 0) ? (bq - 1) : (a == 1) ? (bq + 1) : 5;
            const int cls = g * 6 + pidx;
            const unsigned slot = atomicAdd(cnt + cls, 1u);
            LIST[(size_t)cls * T + slot] = row; WTS[((size_t)cls * T + slot) * 2] = wa; WTS[((size_t)cls * T + slot) * 2 + 1] = wb;
            c.SS[row] = 0.f;
        }
    }
}
struct MoeTab { LAS int* cls; LAS int* til; LAS int* cntv; int ntiles; };
__device__ __forceinline__ MoeTab moe_table(const Ctx& c, int layer) {
    MoeTab mt; mt.cls = (LAS int*)(c.lds + MISC_OFF - 4096); mt.til = mt.cls + MAXCT; mt.cntv = mt.til + MAXCT;
    __syncthreads();
    if (c.tid == 0) { const unsigned* cnt = c.ctl + CW_CNT + layer * 32; int n = 0;
        for (int k = 0; k < NCLS; ++k) { const int cv = (int)__hip_atomic_load(cnt + k, __ATOMIC_RELAXED, __HIP_MEMORY_SCOPE_AGENT); mt.cntv[k] = cv; const int nt = (cv + 255) >> 8;
            for (int t = 0; t < nt && n < MAXCT; ++t) { mt.cls[n] = k; mt.til[n] = t; ++n; } }
        mt.cntv[NCLS] = n; }
    __syncthreads();
    mt.ntiles = mt.cntv[NCLS];
    return mt;
}
__device__ __forceinline__ void cls_experts(int cls, int& ea, int& eb) { const int g = cls / 6, pi = cls - g * 6; const int a = pi < 3 ? 0 : (pi < 5 ? 1 : 2); const int b = pi < 3 ? pi + 1 : (pi < 5 ? pi - 1 : 3); ea = g * 4 + a; eb = g * 4 + b; }
__device__ __forceinline__ void gu_simple(const Ctx& c, const LayerW& w, int layer) {
    const MoeTab mt = moe_table(c, layer);
    const bf16_t* XN = (const bf16_t*)((unsigned char*)c.Z + MZ_XN); bf16_t* HID = (bf16_t*)((unsigned char*)c.Z + MZ_HID);
    const int* LIST = (const int*)((unsigned char*)c.Z + MZ_LIST); const float* WTS = (const float*)((unsigned char*)c.Z + MZ_WTS);
    const int nwt = mt.ntiles * 256;
    for (int t = c.wg * 8 + c.wave; t < nwt; t += c.G * 8) {
        const int ct = t >> 8, rem = t & 255, mi = rem >> 4, ni = rem & 15, sel = ni >> 3, hc0 = (ni & 7) * 64;
        const int cls = mt.cls[ct], til = mt.til[ct], valid = min(256, mt.cntv[cls] - 256 * til);
        int ea, eb; cls_experts(cls, ea, eb); const int e = sel ? eb : ea;
        const int* lst = LIST + (size_t)cls * T + 256 * til;
        const int ar = mi * 16 + (c.lane & 15); const int tok = lst[ar < valid ? ar : 0];
        f32x4 ag[4], au[4]; ZERO_ACC(ag); ZERO_ACC(au);
        const bf16_t* Bg = w.Bgu + (size_t)e * 1024 * 1024; const int brow = 256 * (hc0 >> 7) + (hc0 & 127);
        sg_acc(ag, XN + (size_t)tok * DM, Bg, DM, brow, DM, c.lane);
        sg_acc(au, XN + (size_t)tok * DM, Bg, DM, brow + 128, DM, c.lane);
#pragma unroll
        for (int r = 0; r < 4; ++r) { const int rr = mi * 16 + (c.lane >> 4) * 4 + r; const float wt = (rr < valid) ? WTS[((size_t)cls * T + 256 * til + rr) * 2 + sel] : 0.f;
#pragma unroll
            for (int j = 0; j < 4; ++j) { const int col = hc0 + 16 * j + (c.lane & 15); HID[((size_t)ct * 256 + rr) * 1024 + sel * 512 + col] = f2bf(siluf_(ag[j][r]) * au[j][r] * wt); } }
    }
}
__device__ __forceinline__ void dn_simple(const Ctx& c, const LayerW& w, int layer) {
    const MoeTab mt = moe_table(c, layer);
    const bf16_t* HID = (const bf16_t*)((unsigned char*)c.Z + MZ_HID); const int* LIST = (const int*)((unsigned char*)c.Z + MZ_LIST);
    const int nwt = mt.ntiles * 256;
    for (int t = c.wg * 8 + c.wave; t < nwt; t += c.G * 8) {
        const int ct = t >> 8, rem = t & 255, mi = rem >> 4, n0 = (rem & 15) * 64;
        const int cls = mt.cls[ct], til = mt.til[ct], valid = min(256, mt.cntv[cls] - 256 * til);
        int ea, eb; cls_experts(cls, ea, eb);
        f32x4 acc[4]; ZERO_ACC(acc);
        const bf16_t* ar = HID + ((size_t)ct * 256 + mi * 16 + (c.lane & 15)) * 1024;
        sg_acc(acc, ar, w.Bdn + (size_t)ea * 1024 * 512, 512, n0, 512, c.lane);
        sg_acc(acc, ar + 512, w.Bdn + (size_t)eb * 1024 * 512, 512, n0, 512, c.lane);
        const int* lst = LIST + (size_t)cls * T + 256 * til;
#pragma unroll
        for (int r = 0; r < 4; ++r) { const int rr = mi * 16 + (c.lane >> 4) * 4 + r; const bool ok = rr < valid; const int tok = ok ? lst[rr] : 0; float sq = 0.f;
#pragma unroll
            for (int j = 0; j < 4; ++j) { const int col = n0 + 16 * j + (c.lane & 15);
                if (ok) { const float hv = c.H[(size_t)tok * DM + col] + acc[j][r]; c.H[(size_t)tok * DM + col] = hv; c.HB[(size_t)tok * DM + col] = f2bf(hv); sq += hv * hv; } }
            sq += __shfl_xor(sq, 1); sq += __shfl_xor(sq, 2); sq += __shfl_xor(sq, 4); sq += __shfl_xor(sq, 8);
            if (ok && (c.lane & 15) == 0) atomicAdd(c.SS + tok, sq); }
    }
}
__device__ __forceinline__ void final_phase(const Ctx& c) {
    const float* fw = c.in[18];
    for (int o = c.wg * 8 + c.wave; o < NB * SEQ; o += c.G * 8) {
        const int b = o >> 11, sidx = o & 2047, row = row_of(b, sidx + NMETA);
        const float rstd = rsqrtf(c.SS[row] * (1.0f / DM) + EPS);
#pragma unroll
        for (int i = 0; i < 4; ++i) { const int col = c.lane * 4 + 256 * i; const f32x4 v = *(const f32x4*)(c.H + (size_t)row * DM + col), wv = *(const f32x4*)(fw + col);
            *(f32x4*)(c.out + (size_t)o * DM + col) = v * rstd * wv; }
    }
}
#define ONE_LAUNCH 1
#define P1_IMPL p1_simple
#define P2_IMPL gla_simple
#define P3_IMPL p3_simple
#define P4_IMPL p4_simple
#define P5_IMPL p5_simple
#define GU_IMPL gu_simple
#define DN_IMPL dn_simple
constexpr int N_PHASES = 28;
struct Params { const float* in[19]; float* out; unsigned char* ws; int ph_lo, ph_hi; };
#ifndef ONE_LAUNCH
#define ONE_LAUNCH 1
#endif
__global__ void __launch_bounds__(512, 2) k_fwd(Params p) {
    extern __shared__ __attribute__((aligned(16))) unsigned char lds_raw[];
    Ctx c;
    c.in[0] = p.in[0]; c.in[1] = p.in[1]; c.in[2] = p.in[2]; c.in[3] = p.in[3]; c.in[4] = p.in[4]; c.in[5] = p.in[5]; c.in[6] = p.in[6]; c.in[7] = p.in[7]; c.in[8] = p.in[8]; c.in[9] = p.in[9];
    c.in[10] = p.in[10]; c.in[11] = p.in[11]; c.in[12] = p.in[12]; c.in[13] = p.in[13]; c.in[14] = p.in[14]; c.in[15] = p.in[15]; c.in[16] = p.in[16]; c.in[17] = p.in[17]; c.in[18] = p.in[18];
    c.out = p.out; c.ws = p.ws; c.lds = (LAS unsigned char*)lds_raw;
    c.tid = threadIdx.x; c.lane = c.tid & 63; c.wave = __builtin_amdgcn_readfirstlane(c.tid >> 6); c.G = gridDim.x; c.wg = blockIdx.x;
    c.ctl = (unsigned*)(p.ws + WS_CTL); c.H = (float*)(p.ws + WS_H); c.HB = (bf16_t*)(p.ws + WS_HB); c.SS = (float*)(p.ws + WS_SS); c.Z = (bf16_t*)(p.ws + WS_Z);
    volatile LAS unsigned* misc = (volatile LAS unsigned*)(c.lds + MISC_OFF);
    if (c.tid < 64) misc[c.tid] = 0u;
    __syncthreads();
    const int lo = p.ph_lo, hi = p.ph_hi;
    XcdBarrier bar; bar.bar = c.ctl + CW_BAR; bar.x = 0; bar.st = misc;
    if (hi - lo > 1) bar = xcd_barrier_post(c.ctl + CW_BAR, misc);
#define FRESH() do { int t_ = threadIdx.x; asm volatile("" : "+v"(t_)); c.tid = t_; c.lane = t_ & 63; c.wave = __builtin_amdgcn_readfirstlane(t_ >> 6); int g_ = blockIdx.x; asm volatile("" : "+s"(g_)); c.wg = g_; } while (0)
#define IN(k) (lo <= (k) && (k) < hi)
#define SEAM(k) do { if (IN(k) && IN((k) + 1)) xcd_barrier(bar); } while (0)
    if (IN(0)) { FRESH(); phase_prep(c); }
    SEAM(0);
    for (int l = 0; l < 2; ++l) {
        const LayerW w = layer_w(c, l);
        const int base = 1 + 13 * l;
        for (int s = 0; s < 2; ++s) {
            const int sb = base + 5 * s, segbase = s ? SEG0_ROWS : 0, segrows = s ? SEG1_ROWS : SEG0_ROWS;
            if (IN(sb + 0)) { FRESH(); P1_IMPL(c, w, segbase, segrows); }
            SEAM(sb + 0);
            if (IN(sb + 1)) { FRESH(); P2_IMPL(c, s); FRESH(); pool_phase(c, s); }
            SEAM(sb + 1);
            if (IN(sb + 2)) { FRESH(); P3_IMPL(c, w, segbase, segrows); FRESH(); ygla_phase(c, w, segrows); }
            SEAM(sb + 2);
            if (IN(sb + 3)) { FRESH(); P4_IMPL(c, w, segrows); }
            SEAM(sb + 3);
            if (IN(sb + 4)) { FRESH(); P5_IMPL(c, w, segbase, segrows); }
            SEAM(sb + 4);
        }
        if (IN(base + 10)) { FRESH(); route_phase(c, w, l); }
        SEAM(base + 10);
        if (IN(base + 11)) { FRESH(); GU_IMPL(c, w, l); }
        SEAM(base + 11);
        if (IN(base + 12)) { FRESH(); DN_IMPL(c, w, l); }
        SEAM(base + 12);
    }
    if (IN(27)) { FRESH(); final_phase(c); }
#undef IN
#undef SEAM
}

extern "C" void kernel_launch(void* const* d_in, const int* in_sizes, int n_in, void* d_out, int out_size, void* d_ws, size_t ws_size, hipStream_t stream) {
    static int grid = 0;
    if (grid == 0) {
        if (n_in != 19 || out_size != NB * SEQ * DM || ws_size < WS_END) { fprintf(stderr, "kernel_launch: unexpected shapes (n_in %d out %d ws %zu need %zu)\n", n_in, out_size, ws_size, (size_t)WS_END); grid = -1; return; }
        int dev = 0, cus = 0, per_cu = 0;
        if (hipGetDevice(&dev) != hipSuccess || hipDeviceGetAttribute(&cus, hipDeviceAttributeMultiprocessorCount, dev) != hipSuccess) { grid = -1; return; }
        if (hipFuncSetAttribute((const void*)k_fwd, hipFuncAttributeMaxDynamicSharedMemorySize, LDS_BYTES) != hipSuccess) { fprintf(stderr, "kernel_launch: hipFuncSetAttribute failed\n"); grid = -1; return; }
        if (hipOccupancyMaxActiveBlocksPerMultiprocessor(&per_cu, (const void*)k_fwd, 512, LDS_BYTES) != hipSuccess || per_cu < 1) fprintf(stderr, "kernel_launch: occupancy query says %d\n", per_cu);
        (void)hipGetLastError();
        grid = cus;
    }
    if (grid < 0) return;
    if (hipMemsetAsync((char*)d_ws + WS_CTL, 0, CTL_BYTES, stream) != hipSuccess) return;
    Params p{};
    for (int i = 0; i < 19; ++i) p.in[i] = (const float*)d_in[i];
    p.out = (float*)d_out; p.ws = (unsigned char*)d_ws;
#if ONE_LAUNCH
    p.ph_lo = 0; p.ph_hi = N_PHASES;
    hipLaunchKernelGGL(k_fwd, dim3(grid), dim3(512), LDS_BYTES, stream, p);
#else
    for (int k = 0; k < N_PHASES; ++k) { p.ph_lo = k; p.ph_hi = k + 1; hipLaunchKernelGGL(k_fwd, dim3(grid), dim3(512), LDS_BYTES, stream, p); }
#endif
}
```

```cpp
#include <hip/hip_runtime.h>
#include <stdint.h>
#include <stdio.h>

typedef unsigned short bf16_t;
typedef short bf16x8 __attribute__((ext_vector_type(8)));
typedef float f32x4 __attribute__((ext_vector_type(4)));
typedef unsigned u32x4 __attribute__((ext_vector_type(4)));
typedef unsigned u32x2 __attribute__((ext_vector_type(2)));
#define LAS __attribute__((address_space(3)))

constexpr int DM = 1024, NB = 16, SEQ = 2048, NMETA = 16, LSEQ = SEQ + NMETA, T = NB * LSEQ;
constexpr int SEG0_LEN = 1040, SEG1_LEN = 1024, SEG0_ROWS = NB * SEG0_LEN, SEG1_ROWS = NB * SEG1_LEN;
constexpr int ZC = 6656;
constexpr int ZQ = 0, ZK = 512, ZV = 1024, ZOG = 2048, ZG = 3072, ZU = 3584, ZG0 = 4608, ZG1 = 5632;
constexpr int IN_COLS = 6160;
constexpr int NCLS = 24, MAXCT = 160;
constexpr float EPS = 1e-6f;

constexpr size_t WS_CTL = 0;
constexpr size_t CTL_BYTES = 65536;
constexpr size_t WS_H = WS_CTL + CTL_BYTES;
constexpr size_t WS_HB = WS_H + (size_t)T * DM * 4;
constexpr size_t WS_SS = WS_HB + (size_t)T * DM * 2;
constexpr size_t WS_Z = WS_SS + (size_t)T * 4;
constexpr size_t Z_BYTES = (size_t)SEG0_ROWS * ZC * 2;
constexpr size_t WS_W0 = WS_Z + Z_BYTES;
constexpr size_t W_IN = 0, W_GRP = W_IN + (size_t)ZC * DM * 2, W_BRG = W_GRP + 4 * 256 * 256 * 2, W_BRP = W_BRG + (size_t)DM * DM * 2, W_OUT = W_BRP + (size_t)DM * DM * 2,
                 W_GU = W_OUT + (size_t)DM * DM * 2, W_DN = W_GU + (size_t)16 * 1024 * 1024 * 2, W_BYTES = W_DN + (size_t)16 * 1024 * 512 * 2;
constexpr size_t WS_STATE = WS_W0 + W_BYTES;
constexpr size_t WS_HALO = WS_STATE + (size_t)256 * 8192 * 4;
constexpr size_t WS_END = WS_HALO + (size_t)16 * 15 * 1024 * 2;
constexpr size_t MZ_XN = 0;
constexpr size_t MZ_HID = MZ_XN + (size_t)T * DM * 2;
constexpr size_t MZ_LIST = MZ_HID + (size_t)MAXCT * 256 * 1024 * 2;
constexpr size_t MZ_WTS = MZ_LIST + (size_t)NCLS * T * 4;
constexpr size_t MZ_END = MZ_WTS + (size_t)NCLS * T * 8;
static_assert(MZ_END <= Z_BYTES, "MoE buffers must fit the z region");
static_assert(WS_END <= (size_t)536870912, "workspace");
static_assert(W_BYTES <= (size_t)NB * SEQ * DM * 4, "layer-1 weights must fit d_out");
constexpr int CW_BAR = 0;
constexpr int CW_CNT = 4096;
constexpr int CW_TICKET = 8192;

constexpr int LDS_BYTES = 160 * 1024;
constexpr int MISC_OFF = LDS_BYTES - 256;

__device__ __forceinline__ float bf2f(bf16_t v) { return __uint_as_float(((unsigned)v) << 16); }
__device__ __forceinline__ bf16_t f2bf(float f) { unsigned u = __float_as_uint(f); u += 0x7FFFu + ((u >> 16) & 1u); return (bf16_t)(u >> 16); }
__device__ __forceinline__ unsigned pk2(float lo, float hi) { return (unsigned)f2bf(lo) | ((unsigned)f2bf(hi) << 16); }
__device__ __forceinline__ float sigmoidf_(float x) { return 1.0f / (1.0f + __expf(-x)); }
__device__ __forceinline__ float siluf_(float x) { return x / (1.0f + __expf(-x)); }
__device__ __forceinline__ float logsigmoidf_(float x) { return fminf(x, 0.f) - __logf(1.0f + __expf(-fabsf(x))); }
template <int M> __device__ __forceinline__ float shx(float v) {
    static_assert(M < 32, "use xsum32");
    return __int_as_float(__builtin_amdgcn_ds_swizzle(__float_as_int(v), 0x1f | (M << 10)));
}
__device__ __forceinline__ float xsum32(float v) { const auto r = __builtin_amdgcn_permlane32_swap(__float_as_uint(v), __float_as_uint(v), false, false); return __uint_as_float(r[0]) + __uint_as_float(r[1]); }
__device__ __forceinline__ float wave_sum(float v) { v += shx<1>(v); v += shx<2>(v); v += shx<4>(v); v += shx<8>(v); v += shx<16>(v); return xsum32(v); }
__device__ __forceinline__ int row_of(int b, int p) { return p < SEG0_LEN ? b * SEG0_LEN + p : SEG0_ROWS + b * SEG1_LEN + (p - SEG0_LEN); }
__device__ __forceinline__ void bp_of(int row, int& b, int& p) { if (row < SEG0_ROWS) { b = row / SEG0_LEN; p = row - b * SEG0_LEN; } else { const int r = row - SEG0_ROWS; b = r >> 10; p = SEG0_LEN + (r & 1023); } }
#define XB_TMO      128
#define XB_XCNT(j)  (256  + 64 * (j))
#define XB_XSUB(j)  (1280 + 64 * (j))
#define XB_XGEN(j)  (2304 + 64 * (j))
#define XB_TOP      3328
#define XB_TOPGEN   3392
#define XCD_BAR_WORDS 3456
#define XB_SPIN_CAP (1u << 18)
#define LAS __attribute__((address_space(3)))

__device__ __forceinline__ unsigned xb_ld(unsigned* p)              { return __hip_atomic_load(p, __ATOMIC_RELAXED, __HIP_MEMORY_SCOPE_AGENT); }
__device__ __forceinline__ unsigned xb_add(unsigned* p, unsigned v) { return __hip_atomic_fetch_add(p, v, __ATOMIC_RELAXED, __HIP_MEMORY_SCOPE_AGENT); }
__device__ __forceinline__ unsigned xb_xcc_id() { return (unsigned)__builtin_amdgcn_s_getreg((3 << 11) | 20) & 0xFu; }
#define XB_SPIN(cond, bar) do { unsigned _sp = 0; while (cond) { __builtin_amdgcn_s_sleep(1); \
    if ((++_sp & 255u) == 0u) { if (xb_ld(&(bar)[XB_TMO])) break; if (_sp > XB_SPIN_CAP) { atomicAdd(&(bar)[XB_TMO], 1u); break; } } } } while (0)

struct XcdBarrier {
    unsigned* bar; unsigned x;
    volatile LAS unsigned* st;
};

__device__ __forceinline__ XcdBarrier xcd_barrier_post(unsigned* bar, volatile LAS unsigned* st) {
    XcdBarrier b; b.bar = bar; b.x = xb_xcc_id(); b.st = st;
    if (threadIdx.x == 0) (void)xb_add(&bar[XB_XCNT(b.x)], 1u);
    return b;
}
__device__ __forceinline__ void xcd_barrier_complete(unsigned* bar, unsigned x, unsigned& nloc, unsigned& nx) {
    const unsigned G = gridDim.x * gridDim.y * gridDim.z;
    unsigned sum, cnt, mine, sp = 0u;
    for (;;) {
        sum = 0u; cnt = 0u; mine = 0u;
#pragma unroll
        for (unsigned j = 0; j < 16; ++j) { const unsigned c = xb_ld(&bar[XB_XCNT(j)]); sum += c; cnt += (c > 0u) ? 1u : 0u; mine = (j == x) ? c : mine; }
        if (sum == G) break;
        __builtin_amdgcn_s_sleep(1);
        if ((++sp & 255u) == 0u) { if (xb_ld(&bar[XB_TMO])) break; if (sp > XB_SPIN_CAP) { atomicAdd(&bar[XB_TMO], 1u); break; } }
    }
    nloc = mine > 0u ? mine : 1u; nx = cnt > 0u ? cnt : 1u;
}

__device__ __forceinline__ void xcd_barrier(const XcdBarrier& b) {
    asm volatile("s_waitcnt vmcnt(0)" ::: "memory");
    __syncthreads();
    if (threadIdx.x == 0) {
        unsigned* bar = b.bar;
        __builtin_amdgcn_s_waitcnt(0);
        unsigned nloc = b.st[0], nx = b.st[1];
        if (nloc == 0u) { xcd_barrier_complete(bar, b.x, nloc, nx); b.st[0] = nloc; b.st[1] = nx; }
        const unsigned old = xb_add(&bar[XB_XSUB(b.x)], 1u);
        const unsigned gen = old / nloc;
        if (old + 1u == (gen + 1u) * nloc) {
            __builtin_amdgcn_fence(__ATOMIC_RELEASE, "agent");
            asm volatile("s_waitcnt vmcnt(0)" ::: "memory");
            const unsigned og = xb_add(&bar[XB_TOP], 1u);
            const unsigned tg = og / nx;
            if (og + 1u == (tg + 1u) * nx) xb_add(&bar[XB_TOPGEN], 1u);
            else XB_SPIN(xb_ld(&bar[XB_TOPGEN]) == tg, bar);
            __builtin_amdgcn_fence(__ATOMIC_ACQUIRE, "agent");
            xb_add(&bar[XB_XGEN(b.x)], 1u);
            asm volatile("s_waitcnt vmcnt(0)" ::: "memory");
        } else {
            XB_SPIN(xb_ld(&bar[XB_XGEN(b.x)]) == gen, bar);
            __builtin_amdgcn_fence(__ATOMIC_ACQUIRE, "agent");
            asm volatile("s_waitcnt vmcnt(0)" ::: "memory");
        }
    }
    __syncthreads();
}
struct Ctx {
    float* out; unsigned char* ws;
    LAS unsigned char* lds; int tid, lane, wave, G, wg;
    unsigned* ctl; float* H; bf16_t* HB; float* SS; bf16_t* Z;
};
__device__ __forceinline__ const float* inp(const Ctx& c, int k) {
    const LAS unsigned* t = (const LAS unsigned*)(c.lds + MISC_OFF + 64) + 2 * k;
    const unsigned lo = __builtin_amdgcn_readfirstlane(t[0]), hi = __builtin_amdgcn_readfirstlane(t[1]);
    return (const float*)(((unsigned long long)hi << 32) | lo);
}
struct LayerW {
    const bf16_t *Bin, *Bgrp, *Bbrg, *Bbrp, *Bout, *Bgu, *Bdn;
    const float *b_gate, *gla_nw, *pool_scale, *norm2_w, *w_rg, *w_re;
};
__device__ __forceinline__ LayerW layer_w(const Ctx& c, int l) {
    LayerW w; const unsigned char* base = (l == 0) ? (c.ws + WS_W0) : (const unsigned char*)c.out;
    w.Bin = (const bf16_t*)(base + W_IN); w.Bgrp = (const bf16_t*)(base + W_GRP); w.Bbrg = (const bf16_t*)(base + W_BRG); w.Bbrp = (const bf16_t*)(base + W_BRP);
    w.Bout = (const bf16_t*)(base + W_OUT); w.Bgu = (const bf16_t*)(base + W_GU); w.Bdn = (const bf16_t*)(base + W_DN);
    w.b_gate = inp(c, 5) + l * 512; w.gla_nw = inp(c, 6) + l * 256; w.pool_scale = inp(c, 8) + l * 1024; w.norm2_w = inp(c, 12) + l * 1024;
    w.w_rg = inp(c, 13) + (size_t)l * 1024 * 4; w.w_re = inp(c, 14) + (size_t)l * 1024 * 16;
    return w;
}

struct CvtItem { const float* src; int ldS, k0, n0; bf16_t* dst; int ldD, drow0; const float* rs; float cs; };
constexpr int CVT_A = 96 * 16, CVT_B = 64, CVT_C = 768, CVT_D = 4096, CVT_E = 2048, CVT_PER_LAYER = CVT_A + CVT_B + CVT_C + CVT_D + CVT_E;
__device__ __forceinline__ void cvt_decode(const Ctx& c, int l, int idx, CvtItem& it) {
    const uintptr_t i9 = (uintptr_t)inp(c, 9), i10 = (uintptr_t)inp(c, 10), i11 = (uintptr_t)inp(c, 11), i15 = (uintptr_t)inp(c, 15), i16 = (uintptr_t)inp(c, 16);
    unsigned char* base = (l == 0) ? (c.ws + WS_W0) : (unsigned char*)c.out;
    it.rs = nullptr; it.cs = 1.0f;
    if (idx < CVT_A) { const int nb = idx >> 4, kb = idx & 15;
        it.src = inp(c, 3) + (size_t)l * DM * IN_COLS; it.ldS = IN_COLS; it.k0 = kb * 64; it.dst = (bf16_t*)(base + W_IN); it.ldD = DM; it.rs = inp(c, 2) + l * DM;
        if (nb < 48) { it.n0 = nb * 64; it.drow0 = nb * 64; if (nb < 8) it.cs = 0.08838834764831845f; }
        else { it.n0 = 3088 + (nb - 48) * 64; it.drow0 = ZU + (nb - 48) * 64; }
        return; }
    idx -= CVT_A;
    if (idx < CVT_B) { const int g = idx >> 4, r = idx & 15, nb = r >> 2, kb = r & 3;
        it.src = inp(c, 7) + (size_t)l * 4 * 65536 + (size_t)g * 65536; it.ldS = 256; it.k0 = kb * 64; it.n0 = nb * 64; it.dst = (bf16_t*)(base + W_GRP) + (size_t)g * 65536; it.ldD = 256; it.drow0 = nb * 64; return; }
    idx -= CVT_B;
    if (idx < CVT_C) { const int m = idx >> 8, r = idx & 255, nb = r >> 4, kb = r & 15;
        it.src = (const float*)(m == 0 ? i9 : (m == 1 ? i10 : i11)) + (size_t)l * DM * DM; it.ldS = DM; it.k0 = kb * 64; it.n0 = nb * 64;
        it.dst = (bf16_t*)(base + (m == 0 ? W_BRG : (m == 1 ? W_BRP : W_OUT))); it.ldD = DM; it.drow0 = nb * 64; return; }
    idx -= CVT_C;
    if (idx < CVT_D) { const int e = idx >> 8, r = idx & 255, rb = r >> 4, kb = r & 15, j = rb >> 2, sub = rb & 3;
        const float* s = (const float*)((sub < 2) ? i15 : i16);
        it.src = s + ((size_t)l * 16 + e) * 1024 * 512; it.ldS = 512; it.k0 = kb * 64; it.n0 = 128 * j + 64 * (sub & 1);
        it.dst = (bf16_t*)(base + W_GU) + (size_t)e * 1024 * 1024; it.ldD = 1024; it.drow0 = rb * 64; return; }
    idx -= CVT_D;
    { const int e = idx >> 7, r = idx & 127, nb = r >> 3, kb = r & 7;
        it.src = inp(c, 17) + ((size_t)l * 16 + e) * 512 * 1024; it.ldS = 1024; it.k0 = kb * 64; it.n0 = nb * 64;
        it.dst = (bf16_t*)(base + W_DN) + (size_t)e * 1024 * 512; it.ldD = 512; it.drow0 = nb * 64; }
}
__device__ __forceinline__ void phase_prep(const Ctx& c) {
    for (int row = c.wg * 8 + c.wave; row < T; row += c.G * 8) {
        int b, p; bp_of(row, b, p);
        const float* src = (p < NMETA) ? (inp(c, 1) + (size_t)p * DM) : (inp(c, 0) + ((size_t)b * SEQ + (p - NMETA)) * DM);
        float ss = 0.f;
#pragma unroll
        for (int i = 0; i < 4; ++i) { const int col = c.lane * 4 + 256 * i; const f32x4 v = *(const f32x4*)(src + col);
            ss += v[0] * v[0] + v[1] * v[1] + v[2] * v[2] + v[3] * v[3];
            *(f32x4*)(c.H + (size_t)row * DM + col) = v;
            u32x2 w; w.x = pk2(v[0], v[1]); w.y = pk2(v[2], v[3]); *(u32x2*)(c.HB + (size_t)row * DM + col) = w; }
        ss = wave_sum(ss);
        if (c.lane == 0) c.SS[row] = ss;
    }
    LAS float* tile = (LAS float*)c.lds;
    for (int idx = c.wg; idx < 2 * CVT_PER_LAYER; idx += c.G) {
        const int l = idx / CVT_PER_LAYER; CvtItem it; cvt_decode(c, l, idx - l * CVT_PER_LAYER, it);
        __syncthreads();
#pragma unroll
        for (int i = 0; i < 8; ++i) { const int e = c.tid + 512 * i, kk = e >> 6, nn = e & 63;
            float v = it.src[(size_t)(it.k0 + kk) * it.ldS + it.n0 + nn] * it.cs; if (it.rs) v *= it.rs[it.k0 + kk];
            tile[kk * 65 + nn] = v; }
        __syncthreads();
#pragma unroll
        for (int i = 0; i < 4; ++i) { const int e = c.tid + 512 * i, nn = e >> 5, kp = e & 31;
            *(unsigned*)(it.dst + (size_t)(it.drow0 + nn) * it.ldD + it.k0 + 2 * kp) = pk2(tile[(2 * kp) * 65 + nn], tile[(2 * kp + 1) * 65 + nn]); }
    }
    __syncthreads();
    for (int idx = c.wg * 512 + c.tid; idx < 2 * 512 * 1024; idx += c.G * 512) {
        const int l = idx >> 19, j = (idx >> 10) & 511, k = idx & 1023;
        const float* wi = inp(c, 3) + (size_t)l * DM * IN_COLS + (size_t)k * IN_COLS + 3072; const float* wu = inp(c, 4) + (size_t)l * 16 * 512 + j;
        float a = 0.f;
#pragma unroll
        for (int r = 0; r < 16; ++r) a += wi[r] * wu[r * 512];
        unsigned char* base = (l == 0) ? (c.ws + WS_W0) : (unsigned char*)c.out;
        ((bf16_t*)(base + W_IN))[(size_t)(ZG + j) * DM + k] = f2bf(a * inp(c, 2)[l * DM + k]);
    }
}

__device__ __forceinline__ void sg_acc(f32x4 (&acc)[4], const bf16_t* arow, const bf16_t* B, int ldb, int brow0, int K, int lane) {
    const bf16_t* ap = arow + 8 * (lane >> 4);
    const bf16_t* bp = B + (size_t)(brow0 + (lane & 15)) * ldb + 8 * (lane >> 4);
    for (int k0 = 0; k0 < K; k0 += 32) {
        const bf16x8 a = *(const bf16x8*)(ap + k0);
#pragma unroll
        for (int j = 0; j < 4; ++j) { const bf16x8 b = *(const bf16x8*)(bp + (size_t)(16 * j) * ldb + k0); acc[j] = __builtin_amdgcn_mfma_f32_16x16x32_bf16(a, b, acc[j], 0, 0, 0); }
    }
}
#define ZERO_ACC(acc) do { _Pragma("unroll") for (int _j = 0; _j < 4; ++_j) acc[_j] = (f32x4){0.f, 0.f, 0.f, 0.f}; } while (0)

__device__ __forceinline__ float p1_act(float v, int col, const float* b_gate) {
    if (col < ZOG) return v;
    if (col < ZG) return siluf_(v);
    if (col < ZU) return logsigmoidf_(v + b_gate[col - ZG]) * 0.0625f;
    if (col < ZG0) return v;
    return sigmoidf_(v);
}

__device__ __forceinline__ void p1_simple(const Ctx& c, const LayerW& w, int segbase, int segrows) {
    const int ntn = ZC / 64, ntiles = (segrows / 16) * ntn;
    for (int t = c.wg * 8 + c.wave; t < ntiles; t += c.G * 8) {
        const int m0 = (t / ntn) * 16, n0 = (t % ntn) * 64;
        f32x4 acc[4]; ZERO_ACC(acc);
        sg_acc(acc, c.HB + (size_t)(segbase + m0 + (c.lane & 15)) * DM, w.Bin, DM, n0, DM, c.lane);
#pragma unroll
        for (int r = 0; r < 4; ++r) { const int m = m0 + (c.lane >> 4) * 4 + r; const float rstd = rsqrtf(c.SS[segbase + m] * (1.0f / DM) + EPS);
#pragma unroll
            for (int j = 0; j < 4; ++j) { const int col = n0 + 16 * j + (c.lane & 15); c.Z[(size_t)m * ZC + col] = f2bf(p1_act(acc[j][r] * rstd, col, w.b_gate)); } }
    }
}

__device__ __forceinline__ void gla_simple(const Ctx& c, int seg) {
    constexpr int ST = 130;
    LAS bf16_t* QE = (LAS bf16_t*)c.lds; LAS bf16_t* QI = QE + 64 * ST; LAS bf16_t* KE = QI + 64 * ST; LAS bf16_t* KI = KE + 64 * ST; LAS bf16_t* KD = KI + 64 * ST;
    LAS float* V = (LAS float*)(c.lds + 5 * 64 * ST * 2);
    LAS float* ATT = V + 4096;
    LAS float* S = ATT + 4096;
    LAS float* EG = S + 8192;
    float* stsave = (float*)(c.ws + WS_STATE);
    for (int chain = c.wg; chain < 256; chain += c.G) {
        const int b = chain >> 4, h = (chain >> 2) & 3, s = chain & 3;
        __syncthreads();
        for (int e = c.tid; e < 8192; e += 512) S[e] = (seg == 0) ? 0.f : stsave[(size_t)chain * 8192 + e];
        const int c_lo = seg == 0 ? 0 : 17, c_hi = seg == 0 ? 17 : 33;
        for (int ch = c_lo; ch < c_hi; ++ch) {
            int r0, nvalid;
            if (seg == 0) { if (ch == 0) { r0 = b * SEG0_LEN; nvalid = 16; } else { r0 = b * SEG0_LEN + 16 + 64 * (ch - 1); nvalid = 64; } }
            else { r0 = b * SEG1_LEN + 64 * (ch - 17); nvalid = 64; }
            const bf16_t* zr = c.Z + (size_t)r0 * ZC;
            __syncthreads();
            if (c.tid < 128) { const int ci = c.tid; float bb = 0.f;
                for (int i = 0; i < 64; ++i) { float q = 0.f, k = 0.f, g = 0.f;
                    if (i < nvalid) { const bf16_t* rp = zr + (size_t)i * ZC + h * 128 + ci; q = bf2f(rp[ZQ]); k = bf2f(rp[ZK]); g = bf2f(rp[ZG]); }
                    bb += g; const float e = __expf(bb), ie = __expf(-bb);
                    QE[i * ST + ci] = f2bf(q * e); QI[i * ST + ci] = f2bf(q * ie); KE[i * ST + ci] = f2bf(k * e); KI[i * ST + ci] = f2bf(k * ie); }
                const float gam = bb; EG[ci] = __expf(gam); bb = 0.f;
                for (int i = 0; i < 64; ++i) { float k = 0.f, g = 0.f;
                    if (i < nvalid) { const bf16_t* rp = zr + (size_t)i * ZC + h * 128 + ci; k = bf2f(rp[ZK]); g = bf2f(rp[ZG]); }
                    bb += g; KD[i * ST + ci] = f2bf(k * __expf(gam - bb)); } }
            for (int e = c.tid; e < 4096; e += 512) { const int i = e >> 6, vv = e & 63; V[e] = (i < nvalid) ? bf2f(zr[(size_t)i * ZC + ZV + h * 256 + s * 64 + vv]) : 0.f; }
            __syncthreads();
            for (int e = c.tid; e < 4096; e += 512) { const int i = e >> 6, j = e & 63; float a = 0.f;
                if (i >= j) { for (int k = 0; k < 128; ++k) a += bf2f(QE[i * ST + k]) * bf2f(KI[j * ST + k]); }
                else { for (int k = 0; k < 128; ++k) a += bf2f(QI[i * ST + k]) * bf2f(KE[j * ST + k]); }
                ATT[e] = bf2f(f2bf(a)); }
            __syncthreads();
            for (int e = c.tid; e < 4096; e += 512) { const int i = e >> 6, vv = e & 63; float o = 0.f;
                for (int j = 0; j < 64; ++j) o += ATT[i * 64 + j] * V[j * 64 + vv];
                for (int k = 0; k < 128; ++k) o += bf2f(QE[i * ST + k]) * bf2f(f2bf(S[k * 64 + vv]));
                if (i < nvalid) c.Z[(size_t)(r0 + i) * ZC + ZV + h * 256 + s * 64 + vv] = f2bf(o); }
            __syncthreads();
            for (int e = c.tid; e < 8192; e += 512) { const int k = e >> 6, vv = e & 63; float a = EG[k] * S[e];
                for (int j = 0; j < 64; ++j) a += bf2f(KD[j * ST + k]) * V[j * 64 + vv];
                S[e] = a; }
        }
        __syncthreads();
        if (seg == 0) for (int e = c.tid; e < 8192; e += 512) stsave[(size_t)chain * 8192 + e] = S[e];
    }
}

__device__ __forceinline__ void pool_phase(const Ctx& c, int seg) {
    const int segbase = seg ? SEG0_ROWS : 0, segrows = seg ? SEG1_ROWS : SEG0_ROWS, seglen = seg ? SEG1_LEN : SEG0_LEN;
    bf16_t* halo = (bf16_t*)(c.ws + WS_HALO);
    const int nitem = segrows * 128;
    for (int it = c.wg * 512 + c.tid; it < nitem; it += c.G * 512) {
        const int r = it >> 7, cc = (it & 127) * 8, b = r / seglen, pl = r - b * seglen, p = seg ? SEG0_LEN + pl : pl;
        const int w = 2 << (cc >> 8);
        const int cnt = (p + 1 < w) ? p + 1 : w;
        float s[8];
#pragma unroll
        for (int j = 0; j < 8; ++j) s[j] = 0.f;
        u32x4 self = (u32x4){0u, 0u, 0u, 0u};
        for (int i = 0; i < cnt; ++i) {
            u32x4 v;
            if (pl - i >= 0) v = *(const u32x4*)(c.Z + (size_t)(r - i) * ZC + ZU + cc);
            else v = *(const u32x4*)(halo + ((size_t)b * 15 + (15 + pl - i)) * 1024 + cc);
            if (i == 0) self = v;
#pragma unroll
            for (int j = 0; j < 4; ++j) { s[2 * j] += __uint_as_float(v[j] << 16); s[2 * j + 1] += __uint_as_float(v[j] & 0xffff0000u); }
        }
        const float inv = 1.0f / (float)cnt; u32x4 o;
#pragma unroll
        for (int j = 0; j < 4; ++j) o[j] = pk2(s[2 * j] * inv - __uint_as_float(self[j] << 16), s[2 * j + 1] * inv - __uint_as_float(self[j] & 0xffff0000u));
        *(u32x4*)(c.HB + (size_t)(segbase + r) * DM + cc) = o;
        if (seg == 0 && pl >= SEG0_LEN - 15) *(u32x4*)(halo + ((size_t)b * 15 + (pl - (SEG0_LEN - 15))) * 1024 + cc) = self;
    }
}

__device__ __forceinline__ void ygla_phase(const Ctx& c, const LayerW& w, int segrows) {
    for (int r = c.wg * 8 + c.wave; r < segrows; r += c.G * 8) {
        bf16_t* zr = c.Z + (size_t)r * ZC; const int col = c.lane * 16;
        const u32x4 o0 = *(const u32x4*)(zr + ZV + col), o1 = *(const u32x4*)(zr + ZV + col + 8);
        const u32x4 g0 = *(const u32x4*)(zr + ZOG + col), g1 = *(const u32x4*)(zr + ZOG + col + 8);
        float o[16], sg[16];
#pragma unroll
        for (int j = 0; j < 4; ++j) { o[2 * j] = __uint_as_float(o0[j] << 16); o[2 * j + 1] = __uint_as_float(o0[j] & 0xffff0000u); o[8 + 2 * j] = __uint_as_float(o1[j] << 16); o[8 + 2 * j + 1] = __uint_as_float(o1[j] & 0xffff0000u);
            sg[2 * j] = __uint_as_float(g0[j] << 16); sg[2 * j + 1] = __uint_as_float(g0[j] & 0xffff0000u); sg[8 + 2 * j] = __uint_as_float(g1[j] << 16); sg[8 + 2 * j + 1] = __uint_as_float(g1[j] & 0xffff0000u); }
        float ss = 0.f;
#pragma unroll
        for (int j = 0; j < 16; ++j) ss += o[j] * o[j];
        ss += shx<1>(ss); ss += shx<2>(ss); ss += shx<4>(ss); ss += shx<8>(ss);
        const float rs = rsqrtf(ss * (1.0f / 256.0f) + EPS);
        const float* nw = w.gla_nw + (col & 255);
        u32x4 y0, y1;
#pragma unroll
        for (int j = 0; j < 4; ++j) { y0[j] = pk2(o[2 * j] * rs * nw[2 * j] * sg[2 * j], o[2 * j + 1] * rs * nw[2 * j + 1] * sg[2 * j + 1]);
            y1[j] = pk2(o[8 + 2 * j] * rs * nw[8 + 2 * j] * sg[8 + 2 * j], o[8 + 2 * j + 1] * rs * nw[8 + 2 * j + 1] * sg[8 + 2 * j + 1]); }
        *(u32x4*)(zr + ZOG + col) = y0; *(u32x4*)(zr + ZOG + col + 8) = y1;
    }
}
__device__ __forceinline__ void p3_simple(const Ctx& c, const LayerW& w, int segbase, int segrows) {
    const int ntiles = (segrows / 16) * 16;
    for (int t = c.wg * 8 + c.wave; t < ntiles; t += c.G * 8) {
        const int m0 = (t >> 4) * 16, n0 = (t & 15) * 64, g = n0 >> 8;
        f32x4 acc[4]; ZERO_ACC(acc);
        sg_acc(acc, c.HB + (size_t)(segbase + m0 + (c.lane & 15)) * DM + 256 * g, w.Bgrp + (size_t)g * 65536, 256, n0 & 255, 256, c.lane);
#pragma unroll
        for (int r = 0; r < 4; ++r) { const int m = m0 + (c.lane >> 4) * 4 + r;
#pragma unroll
            for (int j = 0; j < 4; ++j) { const int col = n0 + 16 * j + (c.lane & 15); c.Z[(size_t)m * ZC + ZQ + col] = f2bf(acc[j][r] * w.pool_scale[col]); } }
    }
}
__device__ __forceinline__ void p4_simple(const Ctx& c, const LayerW& w, int segrows) {
    const int ntiles = (segrows / 16) * 16;
    for (int t = c.wg * 8 + c.wave; t < ntiles; t += c.G * 8) {
        const int m0 = (t >> 4) * 16, n0 = (t & 15) * 64;
        f32x4 a1[4], a2[4]; ZERO_ACC(a1); ZERO_ACC(a2);
        sg_acc(a1, c.Z + (size_t)(m0 + (c.lane & 15)) * ZC + ZOG, w.Bbrg, DM, n0, DM, c.lane);
        sg_acc(a2, c.Z + (size_t)(m0 + (c.lane & 15)) * ZC + ZQ, w.Bbrp, DM, n0, DM, c.lane);
#pragma unroll
        for (int r = 0; r < 4; ++r) { const int m = m0 + (c.lane >> 4) * 4 + r; bf16_t* zr = c.Z + (size_t)m * ZC;
#pragma unroll
            for (int j = 0; j < 4; ++j) { const int col = n0 + 16 * j + (c.lane & 15); zr[ZV + col] = f2bf(bf2f(zr[ZG0 + col]) * a1[j][r] + bf2f(zr[ZG1 + col]) * a2[j][r]); } }
    }
}
__device__ __forceinline__ void p5_simple(const Ctx& c, const LayerW& w, int segbase, int segrows) {
    const int ntiles = (segrows / 16) * 16;
    for (int t = c.wg * 8 + c.wave; t < ntiles; t += c.G * 8) {
        const int m0 = (t >> 4) * 16, n0 = (t & 15) * 64;
        f32x4 acc[4]; ZERO_ACC(acc);
        sg_acc(acc, c.Z + (size_t)(m0 + (c.lane & 15)) * ZC + ZV, w.Bout, DM, n0, DM, c.lane);
#pragma unroll
        for (int r = 0; r < 4; ++r) { const int m = segbase + m0 + (c.lane >> 4) * 4 + r;
#pragma unroll
            for (int j = 0; j < 4; ++j) { const int col = n0 + 16 * j + (c.lane & 15); c.H[(size_t)m * DM + col] += acc[j][r]; } }
    }
}

__device__ __forceinline__ void route_phase(const Ctx& c, const LayerW& w, int layer) {
    LAS float* WR = (LAS float*)c.lds;
    for (int e = c.tid; e < 20 * 1024; e += 512) { const int j = e >> 10, k = e & 1023; WR[e] = (j < 4) ? w.w_rg[k * 4 + j] : w.w_re[k * 16 + (j - 4)]; }
    __syncthreads();
    bf16_t* XN = (bf16_t*)((unsigned char*)c.Z + MZ_XN); int* LIST = (int*)((unsigned char*)c.Z + MZ_LIST); float* WTS = (float*)((unsigned char*)c.Z + MZ_WTS);
    unsigned* cnt = c.ctl + CW_CNT + layer * 32;
    for (int row = c.wg * 8 + c.wave; row < T; row += c.G * 8) {
        const float* hr = c.H + (size_t)row * DM; float x[16]; float ss = 0.f;
#pragma unroll
        for (int i = 0; i < 4; ++i) { const f32x4 v = *(const f32x4*)(hr + c.lane * 4 + 256 * i); x[4 * i] = v[0]; x[4 * i + 1] = v[1]; x[4 * i + 2] = v[2]; x[4 * i + 3] = v[3]; ss += v[0] * v[0] + v[1] * v[1] + v[2] * v[2] + v[3] * v[3]; }
        ss = wave_sum(ss);
        const float rstd = rsqrtf(ss * (1.0f / DM) + EPS);
#pragma unroll
        for (int i = 0; i < 4; ++i) { const f32x4 nw = *(const f32x4*)(w.norm2_w + c.lane * 4 + 256 * i);
#pragma unroll
            for (int j = 0; j < 4; ++j) x[4 * i + j] = x[4 * i + j] * rstd * nw[j];
            u32x2 pk; pk.x = pk2(x[4 * i], x[4 * i + 1]); pk.y = pk2(x[4 * i + 2], x[4 * i + 3]); *(u32x2*)(XN + (size_t)row * DM + c.lane * 4 + 256 * i) = pk; }
        float mylg = 0.f;
#pragma unroll 1
        for (int j = 0; j < 20; ++j) { float a = 0.f;
#pragma unroll
            for (int i = 0; i < 4; ++i) { const f32x4 wv = *(const LAS f32x4*)(WR + j * 1024 + c.lane * 4 + 256 * i); a += x[4 * i] * wv[0] + x[4 * i + 1] * wv[1] + x[4 * i + 2] * wv[2] + x[4 * i + 3] * wv[3]; }
            a = wave_sum(a); mylg = (c.lane == j) ? a : mylg; }
        float lg[20];
#pragma unroll
        for (int j = 0; j < 20; ++j) lg[j] = __int_as_float(__builtin_amdgcn_readlane(__float_as_int(mylg), j));
        if (c.lane == 0) {
            int g = 0; float gm = lg[0];
#pragma unroll
            for (int j = 1; j < 4; ++j) if (lg[j] > gm) { gm = lg[j]; g = j; }
            float den = 0.f;
#pragma unroll
            for (int j = 0; j < 4; ++j) den += __expf(lg[j] - gm);
            const float pg = 1.0f / den;
            float le[4];
#pragma unroll
            for (int j = 0; j < 4; ++j) le[j] = (g == 0) ? +lg[4 + j] : (g == 1) ? +lg[8 + j] : (g == 2) ? +lg[12 + j] : +lg[16 + j];
            int i1 = 0; float m1 = le[0];
#pragma unroll
            for (int j = 1; j < 4; ++j) if (le[j] > m1) { m1 = le[j]; i1 = j; }
            int i2 = -1; float m2 = -3.0e38f;
#pragma unroll
            for (int j = 0; j < 4; ++j) if (j != i1 && le[j] > m2) { m2 = le[j]; i2 = j; }
            const float w1 = pg / (1.0f + __expf(m2 - m1)), w2 = pg - w1;
            const int a = i1 < i2 ? +i1 : +i2, bq = i1 < i2 ? +i2 : +i1; const float wa = i1 < i2 ? +w1 : +w2, wb = i1 < i2 ? +w2 : +w1;
            const int pidx = (a == 0) ? (bq - 1) : (a == 1) ? (bq + 1) : 5;
            const int cls = g * 6 + pidx;
            const unsigned slot = atomicAdd(cnt + cls, 1u);
            LIST[(size_t)cls * T + slot] = row; WTS[((size_t)cls * T + slot) * 2] = wa; WTS[((size_t)cls * T + slot) * 2 + 1] = wb;
            c.SS[row] = 0.f;
        }
    }
}
struct MoeTab { LAS int* cls; LAS int* til; LAS int* cntv; int ntiles; };
__device__ __forceinline__ MoeTab moe_table(const Ctx& c, int layer) {
    MoeTab mt; mt.cls = (LAS int*)(c.lds + MISC_OFF - 4096); mt.til = mt.cls + MAXCT; mt.cntv = mt.til + MAXCT;
    __syncthreads();
    if (c.tid == 0) { const unsigned* cnt = c.ctl + CW_CNT + layer * 32; int n = 0;
        for (int k = 0; k < NCLS; ++k) { const int cv = (int)__hip_atomic_load(cnt + k, __ATOMIC_RELAXED, __HIP_MEMORY_SCOPE_AGENT); mt.cntv[k] = cv; const int nt = (cv + 255) >> 8;
            for (int t = 0; t < nt && n < MAXCT; ++t) { mt.cls[n] = k; mt.til[n] = t; ++n; } }
        mt.cntv[NCLS] = n; }
    __syncthreads();
    mt.ntiles = mt.cntv[NCLS];
    return mt;
}
__device__ __forceinline__ void cls_experts(int cls, int& ea, int& eb) { const int g = cls / 6, pi = cls - g * 6; const int a = pi < 3 ? 0 : (pi < 5 ? 1 : 2); const int b = pi < 3 ? pi + 1 : (pi < 5 ? pi - 1 : 3); ea = g * 4 + a; eb = g * 4 + b; }
__device__ __forceinline__ void gu_simple(const Ctx& c, const LayerW& w, int layer) {
    const MoeTab mt = moe_table(c, layer);
    const bf16_t* XN = (const bf16_t*)((unsigned char*)c.Z + MZ_XN); bf16_t* HID = (bf16_t*)((unsigned char*)c.Z + MZ_HID);
    const int* LIST = (const int*)((unsigned char*)c.Z + MZ_LIST); const float* WTS = (const float*)((unsigned char*)c.Z + MZ_WTS);
    const int nwt = mt.ntiles * 256;
    for (int t = c.wg * 8 + c.wave; t < nwt; t += c.G * 8) {
        const int ct = t >> 8, rem = t & 255, mi = rem >> 4, ni = rem & 15, sel = ni >> 3, hc0 = (ni & 7) * 64;
        const int cls = mt.cls[ct], til = mt.til[ct], valid = min(256, mt.cntv[cls] - 256 * til);
        int ea, eb; cls_experts(cls, ea, eb); const int e = sel ? eb : ea;
        const int* lst = LIST + (size_t)cls * T + 256 * til;
        const int ar = mi * 16 + (c.lane & 15); const int tok = lst[ar < valid ? ar : 0];
        f32x4 ag[4], au[4]; ZERO_ACC(ag); ZERO_ACC(au);
        const bf16_t* Bg = w.Bgu + (size_t)e * 1024 * 1024; const int brow = 256 * (hc0 >> 7) + (hc0 & 127);
        sg_acc(ag, XN + (size_t)tok * DM, Bg, DM, brow, DM, c.lane);
        sg_acc(au, XN + (size_t)tok * DM, Bg, DM, brow + 128, DM, c.lane);
#pragma unroll
        for (int r = 0; r < 4; ++r) { const int rr = mi * 16 + (c.lane >> 4) * 4 + r; const float wt = (rr < valid) ? WTS[((size_t)cls * T + 256 * til + rr) * 2 + sel] : 0.f;
#pragma unroll
            for (int j = 0; j < 4; ++j) { const int col = hc0 + 16 * j + (c.lane & 15); HID[((size_t)ct * 256 + rr) * 1024 + sel * 512 + col] = f2bf(siluf_(ag[j][r]) * au[j][r] * wt); } }
    }
}
__device__ __forceinline__ void dn_simple(const Ctx& c, const LayerW& w, int layer) {
    const MoeTab mt = moe_table(c, layer);
    const bf16_t* HID = (const bf16_t*)((unsigned char*)c.Z + MZ_HID); const int* LIST = (const int*)((unsigned char*)c.Z + MZ_LIST);
    const int nwt = mt.ntiles * 256;
    for (int t = c.wg * 8 + c.wave; t < nwt; t += c.G * 8) {
        const int ct = t >> 8, rem = t & 255, mi = rem >> 4, n0 = (rem & 15) * 64;
        const int cls = mt.cls[ct], til = mt.til[ct], valid = min(256, mt.cntv[cls] - 256 * til);
        int ea, eb; cls_experts(cls, ea, eb);
        f32x4 acc[4]; ZERO_ACC(acc);
        const bf16_t* ar = HID + ((size_t)ct * 256 + mi * 16 + (c.lane & 15)) * 1024;
        sg_acc(acc, ar, w.Bdn + (size_t)ea * 1024 * 512, 512, n0, 512, c.lane);
        sg_acc(acc, ar + 512, w.Bdn + (size_t)eb * 1024 * 512, 512, n0, 512, c.lane);
        const int* lst = LIST + (size_t)cls * T + 256 * til;
#pragma unroll
        for (int r = 0; r < 4; ++r) { const int rr = mi * 16 + (c.lane >> 4) * 4 + r; const bool ok = rr < valid; const int tok = ok ? lst[rr] : 0; float sq = 0.f;
#pragma unroll
            for (int j = 0; j < 4; ++j) { const int col = n0 + 16 * j + (c.lane & 15);
                if (ok) { const float hv = c.H[(size_t)tok * DM + col] + acc[j][r]; c.H[(size_t)tok * DM + col] = hv; c.HB[(size_t)tok * DM + col] = f2bf(hv); sq += hv * hv; } }
            sq += shx<1>(sq); sq += shx<2>(sq); sq += shx<4>(sq); sq += shx<8>(sq);
            if (ok && (c.lane & 15) == 0) atomicAdd(c.SS + tok, sq); }
    }
}
__device__ __forceinline__ void final_phase(const Ctx& c) {
    const float* fw = inp(c, 18);
    for (int o = c.wg * 8 + c.wave; o < NB * SEQ; o += c.G * 8) {
        const int b = o >> 11, sidx = o & 2047, row = row_of(b, sidx + NMETA);
        const float rstd = rsqrtf(c.SS[row] * (1.0f / DM) + EPS);
#pragma unroll
        for (int i = 0; i < 4; ++i) { const int col = c.lane * 4 + 256 * i; const f32x4 v = *(const f32x4*)(c.H + (size_t)row * DM + col), wv = *(const f32x4*)(fw + col);
            *(f32x4*)(c.out + (size_t)o * DM + col) = v * rstd * wv; }
    }
}
namespace og {
constexpr int BM = 256, BK = 64, HALF = 128, HTB = HALF * BK * 2, STAGE_BYTES = 8 * HTB;
__device__ __forceinline__ int lds_byte(int r, int c) { const int st = (r >> 4) * 2 + (c >> 5), rr = r & 15, cc = c & 31, ob = rr * 64 + cc * 2; return st * 1024 + (ob ^ (((ob >> 9) & 1) << 5)); }
__device__ __forceinline__ void stage_rc(int b, int& R, int& C) { const int st = b / 1024, sb = b % 1024, swz = sb ^ (((sb >> 9) & 1) << 5); R = (st >> 1) * 16 + swz / 64; C = (st & 1) * 32 + (swz % 64) / 2; }
__device__ __forceinline__ int perm32(int rho) { const int n = rho >> 4, i = rho & 15; return 8 * (i >> 2) + 4 * n + (i & 3); }
__device__ __forceinline__ unsigned cvt_pk_bf16(float lo, float hi) { unsigned r; asm volatile("v_cvt_pk_bf16_f32 %0, %1, %2" : "=v"(r) : "v"(lo), "v"(hi)); return r; }

struct UD { const char* A; const char* B; const int* gl; int gvalid; int mid; int p0, p1, p2, p3; };

typedef f32x4 Acc[2][2][4][2];

template <class Epi, class Sched, bool GATHER>
__device__ __forceinline__ void gemm_run(LAS unsigned char* lds, const Sched& S, const Epi& E, const unsigned lda, const unsigned ldb, const int nt) {
    int tid = threadIdx.x; asm volatile("" : "+v"(tid));
    const int wid = __builtin_amdgcn_readfirstlane(tid >> 6), lane = tid & 63, wr = wid >> 2, wc = wid & 3, fr = lane & 15, fq = lane >> 4;
    unsigned voffB[2];
#pragma unroll
    for (int i = 0; i < 2; ++i) { int R, C; stage_rc(tid * 16 + i * 8192, R, C); const int Rb = (R & ~31) + perm32(R & 31); voffB[i] = (unsigned)Rb * ldb + (unsigned)C * 2u; }
    const size_t kstep = (size_t)(BK * 2);
    const size_t hstepB = (size_t)HALF * ldb;
    const size_t hstepA = GATHER ? (size_t)0 : (size_t)HALF * lda;
    const unsigned ldsw = (unsigned)wid * 1024u;
    const int aoff = lds_byte(wr * 64 + fr, fq * 8), boff = lds_byte(wc * 32 + fr, fq * 8);
#define OG_SA(b, h) (((b) * 2 + (h)) * HTB)
#define OG_SB(b, h) ((4 + (b) * 2 + (h)) * HTB)
#define OG_STAGE(bufoff, gbase, voff) do { _Pragma("unroll") for (int _i = 0; _i < 2; ++_i) \
        __builtin_amdgcn_global_load_lds((const unsigned*)((const char*)(gbase) + (voff)[_i]), (LAS unsigned*)(lds + (bufoff) + ldsw + _i * 8192), 16, 0, 0); } while (0)
#define OG_LDA(dst, b, h) do { _Pragma("unroll") for (int m = 0; m < 4; ++m) _Pragma("unroll") for (int k = 0; k < 2; ++k) dst[m][k] = *(const LAS bf16x8*)(lds + OG_SA(b, h) + aoff + m * 2048 + k * 1024); } while (0)
#define OG_LDB(dst, b, h) do { _Pragma("unroll") for (int n = 0; n < 2; ++n) _Pragma("unroll") for (int k = 0; k < 2; ++k) dst[n][k] = *(const LAS bf16x8*)(lds + OG_SB(b, h) + boff + n * 2048 + k * 1024); } while (0)
#define OG_MMA(ai, bj, At, Bt) do { __builtin_amdgcn_s_setprio(1); _Pragma("unroll") for (int m = 0; m < 4; ++m) _Pragma("unroll") for (int n = 0; n < 2; ++n) _Pragma("unroll") for (int k = 0; k < 2; ++k) \
        acc[ai][bj][m][n] = __builtin_amdgcn_mfma_f32_16x16x32_bf16(Bt[n][k], At[m][k], acc[ai][bj][m][n], 0, 0, 0); __builtin_amdgcn_s_setprio(0); } while (0)
#define OG_WAIT_V(n) asm volatile("s_waitcnt vmcnt(" #n ")" ::: "memory")
#define OG_WAIT_L(n) asm volatile("s_waitcnt lgkmcnt(" #n ")" ::: "memory")
#define OG_BAR __builtin_amdgcn_s_barrier()
#define OG_SCHED __builtin_amdgcn_sched_barrier(0)
#define OG_SETOFF(dst, u) do { int _t = threadIdx.x; asm volatile("" : "+v"(_t)); _Pragma("unroll") for (int _i = 0; _i < 2; ++_i) { int _R, _C; stage_rc(_t * 16 + _i * 8192, _R, _C); \
        _Pragma("unroll") for (int _h = 0; _h < 2; ++_h) { const int _r = _h * HALF + _R; \
        int _row = _r; if (GATHER) _row = (u).gl[_r < (u).gvalid ? _r : 0]; dst[_h][_i] = (unsigned)_row * lda + (unsigned)_C * 2u; } } } while (0)
    UD cur, nxt; int ui = 0;
    if (!S.get(0, cur)) return;
    Acc acc;
    { float z0 = 0.f; asm volatile("" : "+v"(z0));
#pragma unroll
    for (int a = 0; a < 2; ++a)
#pragma unroll
        for (int b = 0; b < 2; ++b)
#pragma unroll
            for (int m = 0; m < 4; ++m)
#pragma unroll
                for (int n = 0; n < 2; ++n) acc[a][b][m][n] = (f32x4){z0, z0, z0, z0}; }
    bf16x8 At[4][2], B0[2][2], B1[2][2];
    unsigned oA[2][2], oN[2][2];
    OG_SETOFF(oA, cur);
    const char* cA = cur.A; const char* cB = cur.B;
    OG_STAGE(OG_SB(0, 0), cB, voffB); OG_STAGE(OG_SB(0, 1), cB + hstepB, voffB); OG_STAGE(OG_SA(0, 0), cA, oA[0]); OG_STAGE(OG_SA(0, 1), cA + hstepA, oA[GATHER ? 1 : 0]);
    if (wr == 1) OG_BAR;
    OG_WAIT_V(2); OG_BAR;
    OG_STAGE(OG_SB(1, 0), cB + kstep, voffB); OG_STAGE(OG_SA(1, 0), cA + kstep, oA[0]); OG_STAGE(OG_SB(1, 1), cB + hstepB + kstep, voffB);
    OG_WAIT_V(6); OG_BAR;
    for (;;) {
        const bool has_next = S.get(ui + 1, nxt);
        const char* nA = has_next ? nxt.A : cA; const char* nB = has_next ? nxt.B : cB;
        if (GATHER) { if (has_next) { OG_SETOFF(oN, nxt); } else {
#pragma unroll
            for (int h = 0; h < 2; ++h)
#pragma unroll
                for (int i = 0; i < 2; ++i) oN[h][i] = oA[h][i]; } }
#pragma unroll 1
        for (int t = 0; t < nt; t += 2) {
            const bool last = (t == nt - 2);
            const char* a1 = cA + (size_t)(t + 1) * kstep;
            const char* a2 = last ? nA : cA + (size_t)(t + 2) * kstep; const char* b2 = last ? nB : cB + (size_t)(t + 2) * kstep;
            const char* a3 = a2 + kstep; const char* b3 = b2 + kstep;
            unsigned o2[2][2];
#pragma unroll
            for (int h = 0; h < 2; ++h)
#pragma unroll
                for (int i = 0; i < 2; ++i) o2[h][i] = (GATHER && last) ? oN[h][i] : oA[h][i];
            OG_LDB(B0, 0, 0); OG_LDB(B1, 0, 1); OG_SCHED; OG_LDA(At, 0, 0); OG_STAGE(OG_SA(1, 1), a1 + hstepA, oA[GATHER ? 1 : 0]);
            OG_WAIT_V(8); OG_WAIT_L(0); OG_BAR; OG_MMA(0, 0, At, B0); OG_MMA(0, 1, At, B1); OG_BAR; OG_SCHED;
            OG_LDA(At, 0, 1); OG_STAGE(OG_SB(0, 0), b2, voffB); OG_STAGE(OG_SB(0, 1), b2 + hstepB, voffB); OG_STAGE(OG_SA(0, 0), a2, o2[0]);
            OG_WAIT_V(8); OG_WAIT_L(0); OG_BAR; OG_MMA(1, 0, At, B0); OG_MMA(1, 1, At, B1); OG_BAR; OG_SCHED;
            OG_LDB(B0, 1, 0); OG_LDB(B1, 1, 1); OG_SCHED; OG_LDA(At, 1, 0); OG_STAGE(OG_SA(0, 1), a2 + hstepA, o2[GATHER ? 1 : 0]);
            OG_WAIT_V(8); OG_WAIT_L(0); OG_BAR; OG_MMA(0, 0, At, B0); OG_MMA(0, 1, At, B1); OG_BAR; OG_SCHED;
            OG_LDA(At, 1, 1); OG_STAGE(OG_SB(1, 0), b3, voffB); OG_STAGE(OG_SB(1, 1), b3 + hstepB, voffB); OG_STAGE(OG_SA(1, 0), a3, o2[0]);
            OG_WAIT_V(8); OG_WAIT_L(0); OG_BAR; OG_MMA(1, 0, At, B0); OG_MMA(1, 1, At, B1); OG_BAR; OG_SCHED;
        }
        if (wr == 0) OG_BAR;
        { int t2 = threadIdx.x; asm volatile("" : "+v"(t2));
          const int w2 = __builtin_amdgcn_readfirstlane(t2 >> 6), wr2 = w2 >> 2, wc2 = w2 & 3, fr2 = t2 & 15, fq2 = (t2 >> 4) & 3;
          if constexpr (Epi::UNIFIED) { E.uni(acc, cur, wr2, wc2, fr2, fq2); }
          else { if (cur.mid) { E.mid(acc, cur, wr2, wc2, fr2, fq2); } else { E(acc, cur, wr2, wc2, fr2, fq2); } } }
        if (!has_next) break;
        if (!cur.mid) { float z0 = 0.f; asm volatile("" : "+v"(z0));
#pragma unroll
            for (int a = 0; a < 2; ++a)
#pragma unroll
                for (int b = 0; b < 2; ++b)
#pragma unroll
                    for (int m = 0; m < 4; ++m)
#pragma unroll
                        for (int n = 0; n < 2; ++n) acc[a][b][m][n] = (f32x4){z0, z0, z0, z0};
        }
        cur = nxt; cA = nA; cB = nB; ++ui;
        if (GATHER) {
#pragma unroll
            for (int h = 0; h < 2; ++h)
#pragma unroll
                for (int i = 0; i < 2; ++i) oA[h][i] = oN[h][i]; }
        if (wr == 1) OG_BAR;
    }
    OG_WAIT_V(0);
    OG_BAR;
#undef OG_SA
#undef OG_SB
#undef OG_STAGE
#undef OG_LDA
#undef OG_LDB
#undef OG_MMA
#undef OG_WAIT_V
#undef OG_WAIT_L
#undef OG_BAR
#undef OG_SCHED
#undef OG_SETOFF
}

__device__ __forceinline__ void grid_tile(int L, int nM, int nN, int& pm, int& pn) {
    const int nwg = nM * nN; int wgid = L; { const int q = nwg / 8, r = nwg % 8, xcd = wgid % 8, off = wgid / 8; wgid = (xcd < r ? xcd * (q + 1) : r * (q + 1) + (xcd - r) * q) + off; }
    const int nig = 8 * nN, gid = wgid / nig, fm = gid * 8, gsz = (nM - fm) < 8 ? (nM - fm) : 8;
    pm = fm + ((wgid % nig) % gsz); pn = (wgid % nig) / gsz;
}
#define OG_ROWS for (int ai = 0; ai < 2; ++ai) _Pragma("unroll") for (int m = 0; m < 4; ++m)
__device__ __forceinline__ int og_row(int cst, int base) { int v = cst; asm volatile("" : "+v"(v)); return v + base; }
#define OG_ROW og_row(ai * 128 + m * 16, wr * 64 + fr)
#define OG_COL(bj) ((bj) * 128 + wc * 32 + fq * 8)
__device__ __forceinline__ void unpack8(const u32x4 v, float (&f)[8]) {
#pragma unroll
    for (int j = 0; j < 4; ++j) { f[2 * j] = __uint_as_float(v[j] << 16); f[2 * j + 1] = __uint_as_float(v[j] & 0xffff0000u); } }
__device__ __forceinline__ u32x4 pack8(const f32x4 a, const f32x4 b) { u32x4 w; w.x = cvt_pk_bf16(a[0], a[1]); w.y = cvt_pk_bf16(a[2], a[3]); w.z = cvt_pk_bf16(b[0], b[1]); w.w = cvt_pk_bf16(b[2], b[3]); return w; }

struct SchedP1 { const char* A; const char* B; int nM, G, wg;
    __device__ __forceinline__ bool get(int i, UD& u) const { const int L = i * G + wg; if (L >= nM * 26) return false; int pm, pn; grid_tile(L, nM, 26, pm, pn);
        u.A = A + (size_t)pm * 256 * 2048; u.B = B + (size_t)pn * 256 * 2048; u.gl = nullptr; u.gvalid = 0; u.mid = 0; u.p0 = pm; u.p1 = pn; u.p2 = 0; u.p3 = 0; return true; } };
struct EpiP1 { static constexpr bool UNIFIED = false; bf16_t* Z; const float* SS; const float* b_gate;
    __device__ __forceinline__ void mid(Acc&, const UD&, int, int, int, int) const {}
    __device__ __forceinline__ void operator()(const Acc& acc, const UD& u, int wr, int wc, int fr, int fq) const {
        const int pm = u.p0, pn = u.p1; const int kind = (pn < 8) ? 0 : (pn < 12) ? 1 : (pn < 14) ? 2 : (pn < 18) ? 0 : 3;
        float bg[2][8];
#pragma unroll
        for (int bj = 0; bj < 2; ++bj)
#pragma unroll
            for (int j = 0; j < 8; ++j) bg[bj][j] = 0.f;
        if (kind == 2) {
#pragma unroll
            for (int bj = 0; bj < 2; ++bj) { const float* bp = b_gate + (pn - 12) * 256 + OG_COL(bj); const f32x4 x0 = *(const f32x4*)bp, x1 = *(const f32x4*)(bp + 4);
#pragma unroll
                for (int j = 0; j < 4; ++j) { bg[bj][j] = x0[j]; bg[bj][4 + j] = x1[j]; } } }
#pragma unroll
        OG_ROWS { const int row = pm * 256 + OG_ROW; const float rstd = rsqrtf(SS[row] * (1.0f / DM) + EPS);
#pragma unroll
            for (int bj = 0; bj < 2; ++bj) { f32x4 v0 = acc[ai][bj][m][0] * rstd, v1 = acc[ai][bj][m][1] * rstd;
                if (kind == 1) {
#pragma unroll
                    for (int j = 0; j < 4; ++j) { v0[j] = siluf_(v0[j]); v1[j] = siluf_(v1[j]); } }
                else if (kind == 2) {
#pragma unroll
                    for (int j = 0; j < 4; ++j) { v0[j] = logsigmoidf_(v0[j] + bg[bj][j]) * 0.0625f; v1[j] = logsigmoidf_(v1[j] + bg[bj][4 + j]) * 0.0625f; } }
                else if (kind == 3) {
#pragma unroll
                    for (int j = 0; j < 4; ++j) { v0[j] = sigmoidf_(v0[j]); v1[j] = sigmoidf_(v1[j]); } }
                *(u32x4*)(Z + (size_t)row * ZC + pn * 256 + OG_COL(bj)) = pack8(v0, v1); } }
    } };
struct SchedP3 { const char* A; const char* B; int nM, G, wg;
    __device__ __forceinline__ bool get(int i, UD& u) const { const int L = i * G + wg; if (L >= nM * 4) return false; int pm, pn; grid_tile(L, nM, 4, pm, pn);
        u.A = A + (size_t)pm * 256 * 2048 + pn * 512; u.B = B + (size_t)pn * 131072; u.gl = nullptr; u.gvalid = 0; u.mid = 0; u.p0 = pm; u.p1 = pn; u.p2 = 0; u.p3 = 0; return true; } };
struct EpiP3 { static constexpr bool UNIFIED = false; bf16_t* Z; const float* scale;
    __device__ __forceinline__ void mid(Acc&, const UD&, int, int, int, int) const {}
    __device__ __forceinline__ void operator()(const Acc& acc, const UD& u, int wr, int wc, int fr, int fq) const {
        const int pm = u.p0, pn = u.p1; f32x4 sc[2][2];
#pragma unroll
        for (int bj = 0; bj < 2; ++bj) { const float* sp = scale + pn * 256 + OG_COL(bj); sc[bj][0] = *(const f32x4*)sp; sc[bj][1] = *(const f32x4*)(sp + 4); }
#pragma unroll
        OG_ROWS { const int row = pm * 256 + OG_ROW;
#pragma unroll
            for (int bj = 0; bj < 2; ++bj) *(u32x4*)(Z + (size_t)row * ZC + ZQ + pn * 256 + OG_COL(bj)) = pack8(acc[ai][bj][m][0] * sc[bj][0], acc[ai][bj][m][1] * sc[bj][1]); }
    } };
struct SchedP4 { const char* Z; const char* Bg; const char* Bp; int nM, G, wg;
    __device__ __forceinline__ bool get(int i, UD& u) const { const int L = (i >> 1) * G + wg; if (L >= nM * 4) return false; int pm, pn; grid_tile(L, nM, 4, pm, pn); const int part = i & 1;
        u.A = Z + (size_t)pm * 256 * (ZC * 2) + (part ? ZQ * 2 : ZOG * 2); u.B = (part ? Bp : Bg) + (size_t)pn * 256 * 2048; u.gl = nullptr; u.gvalid = 0; u.mid = part ? 0 : 1; u.p0 = pm; u.p1 = pn; u.p2 = 0; u.p3 = 0; return true; } };
struct EpiP4 { static constexpr bool UNIFIED = true; bf16_t* Z;
    __device__ __forceinline__ void uni(Acc& acc, const UD& u, int wr, int wc, int fr, int fq) const {
        const int pm = u.p0, pn = u.p1; const bool mid = u.mid != 0;
#pragma unroll
        OG_ROWS { const int row = pm * 256 + OG_ROW;
#pragma unroll
            for (int bj = 0; bj < 2; ++bj) { bf16_t* zp = Z + (size_t)row * ZC + pn * 256 + OG_COL(bj); float g0[8], g1[8]; unpack8(*(const u32x4*)(zp + ZG0), g0); unpack8(*(const u32x4*)(zp + ZG1), g1);
                f32x4 v0, v1;
#pragma unroll
                for (int j = 0; j < 4; ++j) { const float a = fmaxf(g1[j], 1e-30f), b = fmaxf(g1[4 + j], 1e-30f);
                    const float fa = mid ? g0[j] * __builtin_amdgcn_rcpf(a) : a, fb = mid ? g0[4 + j] * __builtin_amdgcn_rcpf(b) : b;
                    v0[j] = acc[ai][bj][m][0][j] * fa; v1[j] = acc[ai][bj][m][1][j] * fb; }
                acc[ai][bj][m][0] = v0; acc[ai][bj][m][1] = v1;
                if (!mid) *(u32x4*)(zp + ZV) = pack8(v0, v1); }
            asm volatile("" ::: "memory"); }
    } };
struct SchedP5 { const char* Z; const char* B; int nM, G, wg;
    __device__ __forceinline__ bool get(int i, UD& u) const { const int L = i * G + wg; if (L >= nM * 4) return false; int pm, pn; grid_tile(L, nM, 4, pm, pn);
        u.A = Z + (size_t)pm * 256 * (ZC * 2) + ZV * 2; u.B = B + (size_t)pn * 256 * 2048; u.gl = nullptr; u.gvalid = 0; u.mid = 0; u.p0 = pm; u.p1 = pn; u.p2 = 0; u.p3 = 0; return true; } };
struct EpiP5 { static constexpr bool UNIFIED = false; float* H;
    __device__ __forceinline__ void mid(Acc&, const UD&, int, int, int, int) const {}
    __device__ __forceinline__ void operator()(const Acc& acc, const UD& u, int wr, int wc, int fr, int fq) const {
        const int pm = u.p0, pn = u.p1;
#pragma unroll
        OG_ROWS { const int row = pm * 256 + OG_ROW;
#pragma unroll
            for (int bj = 0; bj < 2; ++bj) { float* hp = H + (size_t)row * DM + pn * 256 + OG_COL(bj); const f32x4 h0 = *(const f32x4*)hp, h1 = *(const f32x4*)(hp + 4);
                *(f32x4*)hp = h0 + acc[ai][bj][m][0]; *(f32x4*)(hp + 4) = h1 + acc[ai][bj][m][1]; }
            asm volatile("" ::: "memory"); }
    } };
struct SchedGU { const char* XN; const char* Bgu; const int* LIST; MoeTab mt; int G, wg;
    __device__ __forceinline__ bool get(int i, UD& u) const { const int L = i * G + wg; if (L >= mt.ntiles * 8) return false; const int ct = L >> 3, sel = (L >> 2) & 1, pn = L & 3;
        const int cls = mt.cls[ct], til = mt.til[ct]; int ea, eb; cls_experts(cls, ea, eb); const int e = sel ? eb : ea;
        u.A = XN; u.B = Bgu + (size_t)e * 2097152 + (size_t)pn * 256 * 2048; u.gl = LIST + (size_t)cls * T + 256 * til; u.gvalid = min(256, mt.cntv[cls] - 256 * til); u.mid = 0;
        u.p0 = ct; u.p1 = pn; u.p2 = sel; u.p3 = cls * T + 256 * til; return true; } };
struct EpiGU { static constexpr bool UNIFIED = false; bf16_t* HID; const float* WTS;
    __device__ __forceinline__ void mid(Acc&, const UD&, int, int, int, int) const {}
    __device__ __forceinline__ void operator()(const Acc& acc, const UD& u, int wr, int wc, int fr, int fq) const {
        const int ct = u.p0, pn = u.p1, sel = u.p2;
#pragma unroll
        OG_ROWS { const int r = OG_ROW; const float wt = (r < u.gvalid) ? WTS[((size_t)u.p3 + r) * 2 + sel] : 0.f; f32x4 v0, v1;
#pragma unroll
            for (int j = 0; j < 4; ++j) { v0[j] = siluf_(acc[ai][0][m][0][j]) * acc[ai][1][m][0][j] * wt; v1[j] = siluf_(acc[ai][0][m][1][j]) * acc[ai][1][m][1][j] * wt; }
            *(u32x4*)(HID + ((size_t)ct * 256 + r) * 1024 + sel * 512 + pn * 128 + wc * 32 + fq * 8) = pack8(v0, v1); }
    } };
struct SchedDN { const char* HID; const char* Bdn; const int* LIST; MoeTab mt; int G, wg;
    __device__ __forceinline__ bool get(int i, UD& u) const { const int L = (i >> 1) * G + wg; if (L >= mt.ntiles * 4) return false; const int ct = L >> 2, pn = L & 3, part = i & 1;
        const int cls = mt.cls[ct], til = mt.til[ct]; int ea, eb; cls_experts(cls, ea, eb); const int e = part ? eb : ea;
        u.A = HID + (size_t)ct * 256 * 2048 + part * 1024; u.B = Bdn + (size_t)e * 1048576 + (size_t)pn * 256 * 1024; u.gl = LIST + (size_t)cls * T + 256 * til; u.gvalid = min(256, mt.cntv[cls] - 256 * til); u.mid = part ? 0 : 1;
        u.p0 = ct; u.p1 = pn; u.p2 = 0; u.p3 = 0; return true; } };
struct EpiDN { static constexpr bool UNIFIED = false; float* H; bf16_t* HB; float* SS;
    __device__ __forceinline__ void mid(Acc&, const UD&, int, int, int, int) const {}
    __device__ __forceinline__ void operator()(const Acc& acc, const UD& u, int wr, int wc, int fr, int fq) const {
        const int pn = u.p1;
#pragma unroll
        OG_ROWS { const int r = OG_ROW; const bool ok = r < u.gvalid; const int tok = ok ? u.gl[r] : 0; float sq = 0.f;
            if (ok) {
#pragma unroll
                for (int bj = 0; bj < 2; ++bj) { const size_t off = (size_t)tok * DM + pn * 256 + OG_COL(bj); const f32x4 h0 = *(const f32x4*)(H + off) + acc[ai][bj][m][0], h1 = *(const f32x4*)(H + off + 4) + acc[ai][bj][m][1];
                    *(f32x4*)(H + off) = h0; *(f32x4*)(H + off + 4) = h1; *(u32x4*)(HB + off) = pack8(h0, h1);
                    sq += h0[0] * h0[0] + h0[1] * h0[1] + h0[2] * h0[2] + h0[3] * h0[3] + h1[0] * h1[0] + h1[1] * h1[1] + h1[2] * h1[2] + h1[3] * h1[3]; } }
            sq += shx<16>(sq); sq = xsum32(sq);
            if (ok && fq == 0) atomicAdd(SS + tok, sq);
            asm volatile("" ::: "memory"); }
    } };
}

__device__ __forceinline__ void p1_opt(const Ctx& c, const LayerW& w, int segbase, int segrows) {
    og::SchedP1 S{(const char*)(c.HB + (size_t)segbase * DM), (const char*)w.Bin, segrows / 256, c.G, c.wg}; og::EpiP1 E{c.Z, c.SS + segbase, w.b_gate};
    og::gemm_run<og::EpiP1, og::SchedP1, false>(c.lds, S, E, 2048u, 2048u, 16);
}
__device__ __forceinline__ void p3_opt(const Ctx& c, const LayerW& w, int segbase, int segrows) {
    og::SchedP3 S{(const char*)(c.HB + (size_t)segbase * DM), (const char*)w.Bgrp, segrows / 256, c.G, c.wg}; og::EpiP3 E{c.Z, w.pool_scale};
    og::gemm_run<og::EpiP3, og::SchedP3, false>(c.lds, S, E, 2048u, 512u, 4);
}
__device__ __forceinline__ void p4_opt(const Ctx& c, const LayerW& w, int segrows) {
    og::SchedP4 S{(const char*)c.Z, (const char*)w.Bbrg, (const char*)w.Bbrp, segrows / 256, c.G, c.wg}; og::EpiP4 E{c.Z};
    og::gemm_run<og::EpiP4, og::SchedP4, false>(c.lds, S, E, (unsigned)(ZC * 2), 2048u, 16);
}
__device__ __forceinline__ void p5_opt(const Ctx& c, const LayerW& w, int segbase, int segrows) {
    og::SchedP5 S{(const char*)c.Z, (const char*)w.Bout, segrows / 256, c.G, c.wg}; og::EpiP5 E{c.H + (size_t)segbase * DM};
    og::gemm_run<og::EpiP5, og::SchedP5, false>(c.lds, S, E, (unsigned)(ZC * 2), 2048u, 16);
}
__device__ __forceinline__ void gu_opt(const Ctx& c, const LayerW& w, int layer) {
    const MoeTab mt = moe_table(c, layer);
    og::SchedGU S{(const char*)c.Z + MZ_XN, (const char*)w.Bgu, (const int*)((const unsigned char*)c.Z + MZ_LIST), mt, c.G, c.wg};
    og::EpiGU E{(bf16_t*)((unsigned char*)c.Z + MZ_HID), (const float*)((const unsigned char*)c.Z + MZ_WTS)};
    og::gemm_run<og::EpiGU, og::SchedGU, true>(c.lds, S, E, 2048u, 2048u, 16);
}
__device__ __forceinline__ void dn_opt(const Ctx& c, const LayerW& w, int layer) {
    const MoeTab mt = moe_table(c, layer);
    og::SchedDN S{(const char*)c.Z + MZ_HID, (const char*)w.Bdn, (const int*)((const unsigned char*)c.Z + MZ_LIST), mt, c.G, c.wg};
    og::EpiDN E{c.H, c.HB, c.SS};
    og::gemm_run<og::EpiDN, og::SchedDN, false>(c.lds, S, E, 2048u, 1024u, 8);
}
#define ONE_LAUNCH 1
#define P1_IMPL p1_opt
#define P2_IMPL gla_simple
#define P3_IMPL p3_opt
#define P4_IMPL p4_opt
#define P5_IMPL p5_opt
#define GU_IMPL gu_opt
#define DN_IMPL dn_opt
constexpr int N_PHASES = 28;
struct Params { const float* in[19]; float* out; unsigned char* ws; int ph_lo, ph_hi; };
#ifndef ONE_LAUNCH
#define ONE_LAUNCH 1
#endif
__global__ void __launch_bounds__(512, 2) k_fwd(Params p) {
    extern __shared__ __attribute__((aligned(16))) unsigned char lds_raw[];
    Ctx c;
    c.out = p.out; c.ws = p.ws; c.lds = (LAS unsigned char*)lds_raw;
    c.tid = threadIdx.x; c.lane = c.tid & 63; c.wave = __builtin_amdgcn_readfirstlane(c.tid >> 6); c.G = gridDim.x; c.wg = blockIdx.x;
    c.ctl = (unsigned*)(p.ws + WS_CTL); c.H = (float*)(p.ws + WS_H); c.HB = (bf16_t*)(p.ws + WS_HB); c.SS = (float*)(p.ws + WS_SS); c.Z = (bf16_t*)(p.ws + WS_Z);
    volatile LAS unsigned* misc = (volatile LAS unsigned*)(c.lds + MISC_OFF);
    if (c.tid < 16) misc[c.tid] = 0u;
    if (c.tid == 0) {
#pragma unroll
        for (int k = 0; k < 19; ++k) { const unsigned long long a = (unsigned long long)p.in[k]; misc[16 + 2 * k] = (unsigned)a; misc[16 + 2 * k + 1] = (unsigned)(a >> 32); } }
    __syncthreads();
    const int lo = p.ph_lo, hi = p.ph_hi;
    if (hi - lo > 1) (void)xcd_barrier_post(c.ctl + CW_BAR, misc);
#define FRESH() do { w = layer_w(c, l); int t_ = threadIdx.x; asm volatile("" : "+v"(t_)); c.tid = t_; c.lane = t_ & 63; c.wave = __builtin_amdgcn_readfirstlane(t_ >> 6); int g_ = blockIdx.x; asm volatile("" : "+s"(g_)); c.wg = g_; } while (0)
#define IN(k) (lo <= (k) && (k) < hi)
#define SEAM(k) do { if (IN(k) && IN((k) + 1)) { XcdBarrier b2; b2.bar = (unsigned*)(c.ws + WS_CTL) + CW_BAR; b2.x = xb_xcc_id(); b2.st = (volatile LAS unsigned*)(c.lds + MISC_OFF); xcd_barrier(b2); } } while (0)
    LayerW w; int l = 0;
    if (IN(0)) { FRESH(); phase_prep(c); }
    SEAM(0);
    for (l = 0; l < 2; ++l) {
        const int base = 1 + 13 * l;
        for (int s = 0; s < 2; ++s) {
            const int sb = base + 5 * s, segbase = s ? SEG0_ROWS : 0, segrows = s ? SEG1_ROWS : SEG0_ROWS;
            if (IN(sb + 0)) { FRESH(); P1_IMPL(c, w, segbase, segrows); }
            SEAM(sb + 0);
            if (IN(sb + 1)) { FRESH(); P2_IMPL(c, s); FRESH(); pool_phase(c, s); }
            SEAM(sb + 1);
            if (IN(sb + 2)) { FRESH(); P3_IMPL(c, w, segbase, segrows); FRESH(); ygla_phase(c, w, segrows); }
            SEAM(sb + 2);
            if (IN(sb + 3)) { FRESH(); P4_IMPL(c, w, segrows); }
            SEAM(sb + 3);
            if (IN(sb + 4)) { FRESH(); P5_IMPL(c, w, segbase, segrows); }
            SEAM(sb + 4);
        }
        if (IN(base + 10)) { FRESH(); route_phase(c, w, l); }
        SEAM(base + 10);
        if (IN(base + 11)) { FRESH(); GU_IMPL(c, w, l); }
        SEAM(base + 11);
        if (IN(base + 12)) { FRESH(); DN_IMPL(c, w, l); }
        SEAM(base + 12);
    }
    l = 1;
    if (IN(27)) { FRESH(); final_phase(c); }
#undef IN
#undef SEAM
}

extern "C" void kernel_launch(void* const* d_in, const int* in_sizes, int n_in, void* d_out, int out_size, void* d_ws, size_t ws_size, hipStream_t stream) {
    static int grid = 0;
    if (grid == 0) {
        if (n_in != 19 || out_size != NB * SEQ * DM || ws_size < WS_END) { fprintf(stderr, "kernel_launch: unexpected shapes (n_in %d out %d ws %zu need %zu)\n", n_in, out_size, ws_size, (size_t)WS_END); grid = -1; return; }
        int dev = 0, cus = 0, per_cu = 0;
        if (hipGetDevice(&dev) != hipSuccess || hipDeviceGetAttribute(&cus, hipDeviceAttributeMultiprocessorCount, dev) != hipSuccess) { grid = -1; return; }
        if (hipFuncSetAttribute((const void*)k_fwd, hipFuncAttributeMaxDynamicSharedMemorySize, LDS_BYTES) != hipSuccess) { fprintf(stderr, "kernel_launch: hipFuncSetAttribute failed\n"); grid = -1; return; }
        if (hipOccupancyMaxActiveBlocksPerMultiprocessor(&per_cu, (const void*)k_fwd, 512, LDS_BYTES) != hipSuccess || per_cu < 1) fprintf(stderr, "kernel_launch: occupancy query says %d\n", per_cu);
        (void)hipGetLastError();
        grid = cus;
    }
    if (grid < 0) return;
    if (hipMemsetAsync((char*)d_ws + WS_CTL, 0, CTL_BYTES, stream) != hipSuccess) return;
    Params p{};
    for (int i = 0; i < 19; ++i) p.in[i] = (const float*)d_in[i];
    p.out = (float*)d_out; p.ws = (unsigned char*)d_ws;
#if ONE_LAUNCH
    p.ph_lo = 0; p.ph_hi = N_PHASES;
    hipLaunchKernelGGL(k_fwd, dim3(grid), dim3(512), LDS_BYTES, stream, p);
#else
    for (int k = 0; k < N_PHASES; ++k) { p.ph_lo = k; p.ph_hi = k + 1; hipLaunchKernelGGL(k_fwd, dim3(grid), dim3(512), LDS_BYTES, stream, p); }
#endif
}
```

```cpp
#include <hip/hip_runtime.h>
#include <stdint.h>
#include <stdio.h>

typedef unsigned short bf16_t;
typedef short bf16x8 __attribute__((ext_vector_type(8)));
typedef float f32x4 __attribute__((ext_vector_type(4)));
typedef float f32x2 __attribute__((ext_vector_type(2)));
typedef unsigned u32x4 __attribute__((ext_vector_type(4)));
typedef unsigned u32x2 __attribute__((ext_vector_type(2)));
#define LAS __attribute__((address_space(3)))

constexpr int DM = 1024, NB = 16, SEQ = 2048, NMETA = 16, LSEQ = SEQ + NMETA, T = NB * LSEQ;
constexpr int SEG0_LEN = 1040, SEG1_LEN = 1024, SEG0_ROWS = NB * SEG0_LEN, SEG1_ROWS = NB * SEG1_LEN;
constexpr int ZC = 6656;
constexpr int ZQ = 0, ZK = 512, ZV = 1024, ZOG = 2048, ZG = 3072, ZU = 3584, ZG0 = 4608, ZG1 = 5632;
constexpr int IN_COLS = 6160;
constexpr int NCLS = 24, MAXCT = 160;
constexpr float EPS = 1e-6f;

constexpr size_t WS_CTL = 0;
constexpr size_t CTL_BYTES = 65536;
constexpr size_t WS_H = WS_CTL + CTL_BYTES;
constexpr size_t WS_HB = WS_H + (size_t)T * DM * 4;
constexpr size_t WS_SS = WS_HB + (size_t)T * DM * 2;
constexpr size_t WS_Z = WS_SS + (size_t)T * 16 * 4;
constexpr size_t Z_BYTES = (size_t)SEG0_ROWS * ZC * 2;
constexpr size_t WS_W0 = WS_Z + Z_BYTES;
constexpr size_t W_IN = 0, W_GRP = W_IN + (size_t)ZC * DM * 2, W_BRG = W_GRP + 4 * 256 * 256 * 2, W_BRP = W_BRG + (size_t)DM * DM * 2, W_OUT = W_BRP + (size_t)DM * DM * 2,
                 W_GU = W_OUT + (size_t)DM * DM * 2, W_DN = W_GU + (size_t)16 * 1024 * 1024 * 2, W_BYTES = W_DN + (size_t)16 * 1024 * 512 * 2;
constexpr size_t WS_STATE = WS_W0 + W_BYTES;
constexpr size_t WS_HALO = WS_STATE + (size_t)256 * 8192 * 4;
constexpr size_t WS_END = WS_HALO + (size_t)16 * 15 * 1024 * 2;
constexpr size_t MZ_XN = 0;
constexpr size_t MZ_HID = MZ_XN + (size_t)T * DM * 2;
constexpr size_t MZ_LIST = MZ_HID + (size_t)MAXCT * 256 * 1024 * 2;
constexpr size_t MZ_WTS = MZ_LIST + (size_t)NCLS * T * 4;
constexpr size_t MZ_END = MZ_WTS + (size_t)NCLS * T * 8;
static_assert(MZ_END <= Z_BYTES, "MoE buffers must fit the z region");
static_assert(WS_END <= (size_t)536870912, "workspace");
static_assert(W_BYTES <= (size_t)NB * SEQ * DM * 4, "layer-1 weights must fit d_out");
constexpr int CW_BAR = 0;
constexpr int CW_CNT = 4096;
constexpr int CW_TICKET = 8192;

constexpr int LDS_BYTES = 160 * 1024;
constexpr int MISC_OFF = LDS_BYTES - 256;

__device__ __forceinline__ float bf2f(bf16_t v) { return __uint_as_float(((unsigned)v) << 16); }
__device__ __forceinline__ bf16_t f2bf(float f) { unsigned u = __float_as_uint(f); u += 0x7FFFu + ((u >> 16) & 1u); return (bf16_t)(u >> 16); }
__device__ __forceinline__ unsigned pk2(float lo, float hi) { return (unsigned)f2bf(lo) | ((unsigned)f2bf(hi) << 16); }
__device__ __forceinline__ float sigmoidf_(float x) { return 1.0f / (1.0f + __expf(-x)); }
__device__ __forceinline__ float siluf_(float x) { return x / (1.0f + __expf(-x)); }
__device__ __forceinline__ float logsigmoidf_(float x) { return fminf(x, 0.f) - __logf(1.0f + __expf(-fabsf(x))); }
template <int M> __device__ __forceinline__ float shx(float v) {
    static_assert(M < 32, "use xsum32");
    return __int_as_float(__builtin_amdgcn_ds_swizzle(__float_as_int(v), 0x1f | (M << 10)));
}
__device__ __forceinline__ float xsum32(float v) { const auto r = __builtin_amdgcn_permlane32_swap(__float_as_uint(v), __float_as_uint(v), false, false); return __uint_as_float(r[0]) + __uint_as_float(r[1]); }
__device__ __forceinline__ float wave_sum(float v) { v += shx<1>(v); v += shx<2>(v); v += shx<4>(v); v += shx<8>(v); v += shx<16>(v); return xsum32(v); }
__device__ __forceinline__ int row_of(int b, int p) { return p < SEG0_LEN ? b * SEG0_LEN + p : SEG0_ROWS + b * SEG1_LEN + (p - SEG0_LEN); }
__device__ __forceinline__ void bp_of(int row, int& b, int& p) { if (row < SEG0_ROWS) { b = row / SEG0_LEN; p = row - b * SEG0_LEN; } else { const int r = row - SEG0_ROWS; b = r >> 10; p = SEG0_LEN + (r & 1023); } }
#define XB_TMO      128
#define XB_XCNT(j)  (256  + 64 * (j))
#define XB_XSUB(j)  (1280 + 64 * (j))
#define XB_XGEN(j)  (2304 + 64 * (j))
#define XB_TOP      3328
#define XB_TOPGEN   3392
#define XCD_BAR_WORDS 3456
#define XB_SPIN_CAP (1u << 18)
#define LAS __attribute__((address_space(3)))

__device__ __forceinline__ unsigned xb_ld(unsigned* p)              { return __hip_atomic_load(p, __ATOMIC_RELAXED, __HIP_MEMORY_SCOPE_AGENT); }
__device__ __forceinline__ unsigned xb_add(unsigned* p, unsigned v) { return __hip_atomic_fetch_add(p, v, __ATOMIC_RELAXED, __HIP_MEMORY_SCOPE_AGENT); }
__device__ __forceinline__ unsigned xb_xcc_id() { return (unsigned)__builtin_amdgcn_s_getreg((3 << 11) | 20) & 0xFu; }
#define XB_SPIN(cond, bar) do { unsigned _sp = 0; while (cond) { __builtin_amdgcn_s_sleep(1); \
    if ((++_sp & 255u) == 0u) { if (xb_ld(&(bar)[XB_TMO])) break; if (_sp > XB_SPIN_CAP) { atomicAdd(&(bar)[XB_TMO], 1u); break; } } } } while (0)

struct XcdBarrier {
    unsigned* bar; unsigned x;
    volatile LAS unsigned* st;
};

__device__ __forceinline__ XcdBarrier xcd_barrier_post(unsigned* bar, volatile LAS unsigned* st) {
    XcdBarrier b; b.bar = bar; b.x = xb_xcc_id(); b.st = st;
    if (threadIdx.x == 0) (void)xb_add(&bar[XB_XCNT(b.x)], 1u);
    return b;
}
__device__ __forceinline__ void xcd_barrier_complete(unsigned* bar, unsigned x, unsigned& nloc, unsigned& nx) {
    const unsigned G = gridDim.x * gridDim.y * gridDim.z;
    unsigned sum, cnt, mine, sp = 0u;
    for (;;) {
        sum = 0u; cnt = 0u; mine = 0u;
#pragma unroll
        for (unsigned j = 0; j < 16; ++j) { const unsigned c = xb_ld(&bar[XB_XCNT(j)]); sum += c; cnt += (c > 0u) ? 1u : 0u; mine = (j == x) ? c : mine; }
        if (sum == G) break;
        __builtin_amdgcn_s_sleep(1);
        if ((++sp & 255u) == 0u) { if (xb_ld(&bar[XB_TMO])) break; if (sp > XB_SPIN_CAP) { atomicAdd(&bar[XB_TMO], 1u); break; } }
    }
    nloc = mine > 0u ? mine : 1u; nx = cnt > 0u ? cnt : 1u;
}

__device__ __forceinline__ void xcd_barrier(const XcdBarrier& b) {
    asm volatile("s_waitcnt vmcnt(0)" ::: "memory");
    __syncthreads();
    if (threadIdx.x == 0) {
        unsigned* bar = b.bar;
        __builtin_amdgcn_s_waitcnt(0);
        unsigned nloc = b.st[0], nx = b.st[1];
        if (nloc == 0u) { xcd_barrier_complete(bar, b.x, nloc, nx); b.st[0] = nloc; b.st[1] = nx; }
        const unsigned old = xb_add(&bar[XB_XSUB(b.x)], 1u);
        const unsigned gen = old / nloc;
        if (old + 1u == (gen + 1u) * nloc) {
            __builtin_amdgcn_fence(__ATOMIC_RELEASE, "agent");
            asm volatile("s_waitcnt vmcnt(0)" ::: "memory");
            const unsigned og = xb_add(&bar[XB_TOP], 1u);
            const unsigned tg = og / nx;
            if (og + 1u == (tg + 1u) * nx) xb_add(&bar[XB_TOPGEN], 1u);
            else XB_SPIN(xb_ld(&bar[XB_TOPGEN]) == tg, bar);
            __builtin_amdgcn_fence(__ATOMIC_ACQUIRE, "agent");
            xb_add(&bar[XB_XGEN(b.x)], 1u);
            asm volatile("s_waitcnt vmcnt(0)" ::: "memory");
        } else {
            XB_SPIN(xb_ld(&bar[XB_XGEN(b.x)]) == gen, bar);
            __builtin_amdgcn_fence(__ATOMIC_ACQUIRE, "agent");
            asm volatile("s_waitcnt vmcnt(0)" ::: "memory");
        }
    }
    __syncthreads();
}
struct Ctx {
    float* out; unsigned char* ws;
    LAS unsigned char* lds; int tid, lane, wave, G, wg;
    unsigned* ctl; float* H; bf16_t* HB; float* SS; bf16_t* Z;
};
__device__ __forceinline__ const float* inp(const Ctx& c, int k) {
    const LAS unsigned* t = (const LAS unsigned*)(c.lds + MISC_OFF + 64) + 2 * k;
    const unsigned lo = __builtin_amdgcn_readfirstlane(t[0]), hi = __builtin_amdgcn_readfirstlane(t[1]);
    return (const float*)(((unsigned long long)hi << 32) | lo);
}
struct LayerW {
    const bf16_t *Bin, *Bgrp, *Bbrg, *Bbrp, *Bout, *Bgu, *Bdn;
    const float *b_gate, *gla_nw, *pool_scale, *norm2_w, *w_rg, *w_re;
};
__device__ __forceinline__ LayerW layer_w(const Ctx& c, int l) {
    LayerW w; const unsigned char* base = (l == 0) ? (c.ws + WS_W0) : (const unsigned char*)c.out;
    w.Bin = (const bf16_t*)(base + W_IN); w.Bgrp = (const bf16_t*)(base + W_GRP); w.Bbrg = (const bf16_t*)(base + W_BRG); w.Bbrp = (const bf16_t*)(base + W_BRP);
    w.Bout = (const bf16_t*)(base + W_OUT); w.Bgu = (const bf16_t*)(base + W_GU); w.Bdn = (const bf16_t*)(base + W_DN);
    w.b_gate = inp(c, 5) + l * 512; w.gla_nw = inp(c, 6) + l * 256; w.pool_scale = inp(c, 8) + l * 1024; w.norm2_w = inp(c, 12) + l * 1024;
    w.w_rg = inp(c, 13) + (size_t)l * 1024 * 4; w.w_re = inp(c, 14) + (size_t)l * 1024 * 16;
    return w;
}

__device__ __forceinline__ float ss_row(const float* SS, int row) { const f32x4* p = (const f32x4*)(SS + (size_t)row * 16); const f32x4 a = p[0], b = p[1], c2 = p[2], d = p[3];
    return (((a[0] + a[1]) + (a[2] + a[3])) + ((b[0] + b[1]) + (b[2] + b[3]))) + (((c2[0] + c2[1]) + (c2[2] + c2[3])) + ((d[0] + d[1]) + (d[2] + d[3]))); }
struct CvtItem { const float* src; int ldS, k0, n0; bf16_t* dst; int ldD, drow0; const float* rs; float cs; };
constexpr int CVT_A = 96 * 16, CVT_B = 64, CVT_C = 768, CVT_D = 4096, CVT_E = 2048, CVT_PER_LAYER = CVT_A + CVT_B + CVT_C + CVT_D + CVT_E;
__device__ __forceinline__ void cvt_decode(const Ctx& c, int l, int idx, CvtItem& it) {
    const uintptr_t i9 = (uintptr_t)inp(c, 9), i10 = (uintptr_t)inp(c, 10), i11 = (uintptr_t)inp(c, 11), i15 = (uintptr_t)inp(c, 15), i16 = (uintptr_t)inp(c, 16);
    unsigned char* base = (l == 0) ? (c.ws + WS_W0) : (unsigned char*)c.out;
    it.rs = nullptr; it.cs = 1.0f;
    if (idx < CVT_A) { const int nb = idx >> 4, kb = idx & 15;
        it.src = inp(c, 3) + (size_t)l * DM * IN_COLS; it.ldS = IN_COLS; it.k0 = kb * 64; it.dst = (bf16_t*)(base + W_IN); it.ldD = DM; it.rs = inp(c, 2) + l * DM;
        if (nb < 48) { it.n0 = nb * 64; it.drow0 = nb * 64; if (nb < 8) it.cs = 0.08838834764831845f; }
        else { it.n0 = 3088 + (nb - 48) * 64; it.drow0 = ZU + (nb - 48) * 64; }
        return; }
    idx -= CVT_A;
    if (idx < CVT_B) { const int g = idx >> 4, r = idx & 15, nb = r >> 2, kb = r & 3;
        it.src = inp(c, 7) + (size_t)l * 4 * 65536 + (size_t)g * 65536; it.ldS = 256; it.k0 = kb * 64; it.n0 = nb * 64; it.dst = (bf16_t*)(base + W_GRP) + (size_t)g * 65536; it.ldD = 256; it.drow0 = nb * 64; return; }
    idx -= CVT_B;
    if (idx < CVT_C) { const int m = idx >> 8, r = idx & 255, nb = r >> 4, kb = r & 15;
        it.src = (const float*)(m == 0 ? i9 : (m == 1 ? i10 : i11)) + (size_t)l * DM * DM; it.ldS = DM; it.k0 = kb * 64; it.n0 = nb * 64;
        it.dst = (bf16_t*)(base + (m == 0 ? W_BRG : (m == 1 ? W_BRP : W_OUT))); it.ldD = DM; it.drow0 = nb * 64; return; }
    idx -= CVT_C;
    if (idx < CVT_D) { const int e = idx >> 8, r = idx & 255, rb = r >> 4, kb = r & 15, j = rb >> 2, sub = rb & 3;
        const float* s = (const float*)((sub < 2) ? i15 : i16);
        it.src = s + ((size_t)l * 16 + e) * 1024 * 512; it.ldS = 512; it.k0 = kb * 64; it.n0 = 128 * j + 64 * (sub & 1);
        it.dst = (bf16_t*)(base + W_GU) + (size_t)e * 1024 * 1024; it.ldD = 1024; it.drow0 = rb * 64; return; }
    idx -= CVT_D;
    { const int e = idx >> 7, r = idx & 127, nb = r >> 3, kb = r & 7;
        it.src = inp(c, 17) + ((size_t)l * 16 + e) * 512 * 1024; it.ldS = 1024; it.k0 = kb * 64; it.n0 = nb * 64;
        it.dst = (bf16_t*)(base + W_DN) + (size_t)e * 1024 * 512; it.ldD = 512; it.drow0 = nb * 64; }
}
__device__ __forceinline__ void phase_prep(const Ctx& c) {
    for (int row = c.wg * 8 + c.wave; row < T; row += c.G * 8) {
        int b, p; bp_of(row, b, p);
        const float* src = (p < NMETA) ? (inp(c, 1) + (size_t)p * DM) : (inp(c, 0) + ((size_t)b * SEQ + (p - NMETA)) * DM);
        float ss = 0.f;
#pragma unroll
        for (int i = 0; i < 4; ++i) { const int col = c.lane * 4 + 256 * i; const f32x4 v = *(const f32x4*)(src + col);
            ss += v[0] * v[0] + v[1] * v[1] + v[2] * v[2] + v[3] * v[3];
            *(f32x4*)(c.H + (size_t)row * DM + col) = v;
            u32x2 w; w.x = pk2(v[0], v[1]); w.y = pk2(v[2], v[3]); *(u32x2*)(c.HB + (size_t)row * DM + col) = w; }
        ss = wave_sum(ss);
        if (c.lane < 16) c.SS[(size_t)row * 16 + c.lane] = (c.lane == 0) ? ss : 0.f;
    }
    LAS float* tile = (LAS float*)c.lds;
    for (int idx = c.wg; idx < 2 * CVT_PER_LAYER; idx += c.G) {
        const int l = idx / CVT_PER_LAYER; CvtItem it; cvt_decode(c, l, idx - l * CVT_PER_LAYER, it);
        __syncthreads();
#pragma unroll
        for (int i = 0; i < 8; ++i) { const int e = c.tid + 512 * i, kk = e >> 6, nn = e & 63;
            float v = it.src[(size_t)(it.k0 + kk) * it.ldS + it.n0 + nn] * it.cs; if (it.rs) v *= it.rs[it.k0 + kk];
            tile[kk * 65 + nn] = v; }
        __syncthreads();
#pragma unroll
        for (int i = 0; i < 4; ++i) { const int e = c.tid + 512 * i, nn = e >> 5, kp = e & 31;
            *(unsigned*)(it.dst + (size_t)(it.drow0 + nn) * it.ldD + it.k0 + 2 * kp) = pk2(tile[(2 * kp) * 65 + nn], tile[(2 * kp + 1) * 65 + nn]); }
    }
    __syncthreads();
    for (int idx = c.wg * 512 + c.tid; idx < 2 * 512 * 1024; idx += c.G * 512) {
        const int l = idx >> 19, j = (idx >> 10) & 511, k = idx & 1023;
        const float* wi = inp(c, 3) + (size_t)l * DM * IN_COLS + (size_t)k * IN_COLS + 3072; const float* wu = inp(c, 4) + (size_t)l * 16 * 512 + j;
        float a = 0.f;
#pragma unroll
        for (int r = 0; r < 16; ++r) a += wi[r] * wu[r * 512];
        unsigned char* base = (l == 0) ? (c.ws + WS_W0) : (unsigned char*)c.out;
        ((bf16_t*)(base + W_IN))[(size_t)(ZG + j) * DM + k] = f2bf(a * inp(c, 2)[l * DM + k]);
    }
}

__device__ __forceinline__ void sg_acc(f32x4 (&acc)[4], const bf16_t* arow, const bf16_t* B, int ldb, int brow0, int K, int lane) {
    const bf16_t* ap = arow + 8 * (lane >> 4);
    const bf16_t* bp = B + (size_t)(brow0 + (lane & 15)) * ldb + 8 * (lane >> 4);
    for (int k0 = 0; k0 < K; k0 += 32) {
        const bf16x8 a = *(const bf16x8*)(ap + k0);
#pragma unroll
        for (int j = 0; j < 4; ++j) { const bf16x8 b = *(const bf16x8*)(bp + (size_t)(16 * j) * ldb + k0); acc[j] = __builtin_amdgcn_mfma_f32_16x16x32_bf16(a, b, acc[j], 0, 0, 0); }
    }
}
#define ZERO_ACC(acc) do { _Pragma("unroll") for (int _j = 0; _j < 4; ++_j) acc[_j] = (f32x4){0.f, 0.f, 0.f, 0.f}; } while (0)

__device__ __forceinline__ float p1_act(float v, int col, const float* b_gate) {
    if (col < ZOG) return v;
    if (col < ZG) return siluf_(v);
    if (col < ZU) return logsigmoidf_(v + b_gate[col - ZG]) * 0.0625f;
    if (col < ZG0) return v;
    return sigmoidf_(v);
}

__device__ __forceinline__ void p1_simple(const Ctx& c, const LayerW& w, int segbase, int segrows) {
    const int ntn = ZC / 64, ntiles = (segrows / 16) * ntn;
    for (int t = c.wg * 8 + c.wave; t < ntiles; t += c.G * 8) {
        const int m0 = (t / ntn) * 16, n0 = (t % ntn) * 64;
        f32x4 acc[4]; ZERO_ACC(acc);
        sg_acc(acc, c.HB + (size_t)(segbase + m0 + (c.lane & 15)) * DM, w.Bin, DM, n0, DM, c.lane);
#pragma unroll
        for (int r = 0; r < 4; ++r) { const int m = m0 + (c.lane >> 4) * 4 + r; const float rstd = rsqrtf(ss_row(c.SS, segbase + m) * (1.0f / DM) + EPS);
#pragma unroll
            for (int j = 0; j < 4; ++j) { const int col = n0 + 16 * j + (c.lane & 15); c.Z[(size_t)m * ZC + col] = f2bf(p1_act(acc[j][r] * rstd, col, w.b_gate)); } }
    }
}

__device__ __forceinline__ void gla_simple(const Ctx& c, int seg) {
    constexpr int ST = 130;
    LAS bf16_t* QE = (LAS bf16_t*)c.lds; LAS bf16_t* QI = QE + 64 * ST; LAS bf16_t* KE = QI + 64 * ST; LAS bf16_t* KI = KE + 64 * ST; LAS bf16_t* KD = KI + 64 * ST;
    LAS float* V = (LAS float*)(c.lds + 5 * 64 * ST * 2);
    LAS float* ATT = V + 4096;
    LAS float* S = ATT + 4096;
    LAS float* EG = S + 8192;
    float* stsave = (float*)(c.ws + WS_STATE);
    for (int chain = c.wg; chain < 256; chain += c.G) {
        const int b = chain >> 4, h = (chain >> 2) & 3, s = chain & 3;
        __syncthreads();
        for (int e = c.tid; e < 8192; e += 512) S[e] = (seg == 0) ? 0.f : stsave[(size_t)chain * 8192 + e];
        const int c_lo = seg == 0 ? 0 : 17, c_hi = seg == 0 ? 17 : 33;
        for (int ch = c_lo; ch < c_hi; ++ch) {
            int r0, nvalid;
            if (seg == 0) { if (ch == 0) { r0 = b * SEG0_LEN; nvalid = 16; } else { r0 = b * SEG0_LEN + 16 + 64 * (ch - 1); nvalid = 64; } }
            else { r0 = b * SEG1_LEN + 64 * (ch - 17); nvalid = 64; }
            const bf16_t* zr = c.Z + (size_t)r0 * ZC;
            __syncthreads();
            if (c.tid < 128) { const int ci = c.tid; float bb = 0.f;
                for (int i = 0; i < 64; ++i) { float q = 0.f, k = 0.f, g = 0.f;
                    if (i < nvalid) { const bf16_t* rp = zr + (size_t)i * ZC + h * 128 + ci; q = bf2f(rp[ZQ]); k = bf2f(rp[ZK]); g = bf2f(rp[ZG]); }
                    bb += g; const float e = __expf(bb), ie = __expf(-bb);
                    QE[i * ST + ci] = f2bf(q * e); QI[i * ST + ci] = f2bf(q * ie); KE[i * ST + ci] = f2bf(k * e); KI[i * ST + ci] = f2bf(k * ie); }
                const float gam = bb; EG[ci] = __expf(gam); bb = 0.f;
                for (int i = 0; i < 64; ++i) { float k = 0.f, g = 0.f;
                    if (i < nvalid) { const bf16_t* rp = zr + (size_t)i * ZC + h * 128 + ci; k = bf2f(rp[ZK]); g = bf2f(rp[ZG]); }
                    bb += g; KD[i * ST + ci] = f2bf(k * __expf(gam - bb)); } }
            for (int e = c.tid; e < 4096; e += 512) { const int i = e >> 6, vv = e & 63; V[e] = (i < nvalid) ? bf2f(zr[(size_t)i * ZC + ZV + h * 256 + s * 64 + vv]) : 0.f; }
            __syncthreads();
            for (int e = c.tid; e < 4096; e += 512) { const int i = e >> 6, j = e & 63; float a = 0.f;
                if (i >= j) { for (int k = 0; k < 128; ++k) a += bf2f(QE[i * ST + k]) * bf2f(KI[j * ST + k]); }
                else { for (int k = 0; k < 128; ++k) a += bf2f(QI[i * ST + k]) * bf2f(KE[j * ST + k]); }
                ATT[e] = bf2f(f2bf(a)); }
            __syncthreads();
            for (int e = c.tid; e < 4096; e += 512) { const int i = e >> 6, vv = e & 63; float o = 0.f;
                for (int j = 0; j < 64; ++j) o += ATT[i * 64 + j] * V[j * 64 + vv];
                for (int k = 0; k < 128; ++k) o += bf2f(QE[i * ST + k]) * bf2f(f2bf(S[k * 64 + vv]));
                if (i < nvalid) c.Z[(size_t)(r0 + i) * ZC + ZV + h * 256 + s * 64 + vv] = f2bf(o); }
            __syncthreads();
            for (int e = c.tid; e < 8192; e += 512) { const int k = e >> 6, vv = e & 63; float a = EG[k] * S[e];
                for (int j = 0; j < 64; ++j) a += bf2f(KD[j * ST + k]) * V[j * 64 + vv];
                S[e] = a; }
        }
        __syncthreads();
        if (seg == 0) for (int e = c.tid; e < 8192; e += 512) stsave[(size_t)chain * 8192 + e] = S[e];
    }
}

__device__ __forceinline__ void pool_phase(const Ctx& c, int seg) {
    const int segbase = seg ? SEG0_ROWS : 0, segrows = seg ? SEG1_ROWS : SEG0_ROWS, seglen = seg ? SEG1_LEN : SEG0_LEN;
    bf16_t* halo = (bf16_t*)(c.ws + WS_HALO);
    const int nitem = segrows * 128;
    for (int it = c.wg * 512 + c.tid; it < nitem; it += c.G * 512) {
        const int r = it >> 7, cc = (it & 127) * 8, b = r / seglen, pl = r - b * seglen, p = seg ? SEG0_LEN + pl : pl;
        const int w = 2 << (cc >> 8);
        const int cnt = (p + 1 < w) ? p + 1 : w;
        float s[8];
#pragma unroll
        for (int j = 0; j < 8; ++j) s[j] = 0.f;
        u32x4 self = (u32x4){0u, 0u, 0u, 0u};
        for (int i = 0; i < cnt; ++i) {
            u32x4 v;
            if (pl - i >= 0) v = *(const u32x4*)(c.Z + (size_t)(r - i) * ZC + ZU + cc);
            else v = *(const u32x4*)(halo + ((size_t)b * 15 + (15 + pl - i)) * 1024 + cc);
            if (i == 0) self = v;
#pragma unroll
            for (int j = 0; j < 4; ++j) { s[2 * j] += __uint_as_float(v[j] << 16); s[2 * j + 1] += __uint_as_float(v[j] & 0xffff0000u); }
        }
        const float inv = 1.0f / (float)cnt; u32x4 o;
#pragma unroll
        for (int j = 0; j < 4; ++j) o[j] = pk2(s[2 * j] * inv - __uint_as_float(self[j] << 16), s[2 * j + 1] * inv - __uint_as_float(self[j] & 0xffff0000u));
        *(u32x4*)(c.HB + (size_t)(segbase + r) * DM + cc) = o;
        if (seg == 0 && pl >= SEG0_LEN - 15) *(u32x4*)(halo + ((size_t)b * 15 + (pl - (SEG0_LEN - 15))) * 1024 + cc) = self;
    }
}

__device__ __forceinline__ void ygla_phase(const Ctx& c, const LayerW& w, int segrows) {
    for (int r = c.wg * 8 + c.wave; r < segrows; r += c.G * 8) {
        bf16_t* zr = c.Z + (size_t)r * ZC; const int col = c.lane * 16;
        const u32x4 o0 = *(const u32x4*)(zr + ZV + col), o1 = *(const u32x4*)(zr + ZV + col + 8);
        const u32x4 g0 = *(const u32x4*)(zr + ZOG + col), g1 = *(const u32x4*)(zr + ZOG + col + 8);
        float o[16], sg[16];
#pragma unroll
        for (int j = 0; j < 4; ++j) { o[2 * j] = __uint_as_float(o0[j] << 16); o[2 * j + 1] = __uint_as_float(o0[j] & 0xffff0000u); o[8 + 2 * j] = __uint_as_float(o1[j] << 16); o[8 + 2 * j + 1] = __uint_as_float(o1[j] & 0xffff0000u);
            sg[2 * j] = __uint_as_float(g0[j] << 16); sg[2 * j + 1] = __uint_as_float(g0[j] & 0xffff0000u); sg[8 + 2 * j] = __uint_as_float(g1[j] << 16); sg[8 + 2 * j + 1] = __uint_as_float(g1[j] & 0xffff0000u); }
        float ss = 0.f;
#pragma unroll
        for (int j = 0; j < 16; ++j) ss += o[j] * o[j];
        ss += shx<1>(ss); ss += shx<2>(ss); ss += shx<4>(ss); ss += shx<8>(ss);
        const float rs = rsqrtf(ss * (1.0f / 256.0f) + EPS);
        const float* nw = w.gla_nw + (col & 255);
        u32x4 y0, y1;
#pragma unroll
        for (int j = 0; j < 4; ++j) { y0[j] = pk2(o[2 * j] * rs * nw[2 * j] * sg[2 * j], o[2 * j + 1] * rs * nw[2 * j + 1] * sg[2 * j + 1]);
            y1[j] = pk2(o[8 + 2 * j] * rs * nw[8 + 2 * j] * sg[8 + 2 * j], o[8 + 2 * j + 1] * rs * nw[8 + 2 * j + 1] * sg[8 + 2 * j + 1]); }
        *(u32x4*)(zr + ZOG + col) = y0; *(u32x4*)(zr + ZOG + col + 8) = y1;
    }
}
__device__ __forceinline__ void p3_simple(const Ctx& c, const LayerW& w, int segbase, int segrows) {
    const int ntiles = (segrows / 16) * 16;
    for (int t = c.wg * 8 + c.wave; t < ntiles; t += c.G * 8) {
        const int m0 = (t >> 4) * 16, n0 = (t & 15) * 64, g = n0 >> 8;
        f32x4 acc[4]; ZERO_ACC(acc);
        sg_acc(acc, c.HB + (size_t)(segbase + m0 + (c.lane & 15)) * DM + 256 * g, w.Bgrp + (size_t)g * 65536, 256, n0 & 255, 256, c.lane);
#pragma unroll
        for (int r = 0; r < 4; ++r) { const int m = m0 + (c.lane >> 4) * 4 + r;
#pragma unroll
            for (int j = 0; j < 4; ++j) { const int col = n0 + 16 * j + (c.lane & 15); c.Z[(size_t)m * ZC + ZQ + col] = f2bf(acc[j][r] * w.pool_scale[col]); } }
    }
}
__device__ __forceinline__ void p4_simple(const Ctx& c, const LayerW& w, int segrows) {
    const int ntiles = (segrows / 16) * 16;
    for (int t = c.wg * 8 + c.wave; t < ntiles; t += c.G * 8) {
        const int m0 = (t >> 4) * 16, n0 = (t & 15) * 64;
        f32x4 a1[4], a2[4]; ZERO_ACC(a1); ZERO_ACC(a2);
        sg_acc(a1, c.Z + (size_t)(m0 + (c.lane & 15)) * ZC + ZOG, w.Bbrg, DM, n0, DM, c.lane);
        sg_acc(a2, c.Z + (size_t)(m0 + (c.lane & 15)) * ZC + ZQ, w.Bbrp, DM, n0, DM, c.lane);
#pragma unroll
        for (int r = 0; r < 4; ++r) { const int m = m0 + (c.lane >> 4) * 4 + r; bf16_t* zr = c.Z + (size_t)m * ZC;
#pragma unroll
            for (int j = 0; j < 4; ++j) { const int col = n0 + 16 * j + (c.lane & 15); zr[ZV + col] = f2bf(bf2f(zr[ZG0 + col]) * a1[j][r] + bf2f(zr[ZG1 + col]) * a2[j][r]); } }
    }
}
__device__ __forceinline__ void p5_simple(const Ctx& c, const LayerW& w, int segbase, int segrows) {
    const int ntiles = (segrows / 16) * 16;
    for (int t = c.wg * 8 + c.wave; t < ntiles; t += c.G * 8) {
        const int m0 = (t >> 4) * 16, n0 = (t & 15) * 64;
        f32x4 acc[4]; ZERO_ACC(acc);
        sg_acc(acc, c.Z + (size_t)(m0 + (c.lane & 15)) * ZC + ZV, w.Bout, DM, n0, DM, c.lane);
#pragma unroll
        for (int r = 0; r < 4; ++r) { const int m = segbase + m0 + (c.lane >> 4) * 4 + r;
#pragma unroll
            for (int j = 0; j < 4; ++j) { const int col = n0 + 16 * j + (c.lane & 15); c.H[(size_t)m * DM + col] += acc[j][r]; } }
    }
}

__device__ __forceinline__ void route_phase(const Ctx& c, const LayerW& w, int layer) {
    LAS float* WR = (LAS float*)c.lds;
    for (int e = c.tid; e < 20 * 1024; e += 512) { const int j = e >> 10, k = e & 1023; WR[e] = (j < 4) ? w.w_rg[k * 4 + j] : w.w_re[k * 16 + (j - 4)]; }
    __syncthreads();
    bf16_t* XN = (bf16_t*)((unsigned char*)c.Z + MZ_XN); int* LIST = (int*)((unsigned char*)c.Z + MZ_LIST); float* WTS = (float*)((unsigned char*)c.Z + MZ_WTS);
    unsigned* cnt = c.ctl + CW_CNT + layer * 32;
    for (int row = c.wg * 8 + c.wave; row < T; row += c.G * 8) {
        const float* hr = c.H + (size_t)row * DM; float x[16]; float ss = 0.f;
#pragma unroll
        for (int i = 0; i < 4; ++i) { const f32x4 v = *(const f32x4*)(hr + c.lane * 4 + 256 * i); x[4 * i] = v[0]; x[4 * i + 1] = v[1]; x[4 * i + 2] = v[2]; x[4 * i + 3] = v[3]; ss += v[0] * v[0] + v[1] * v[1] + v[2] * v[2] + v[3] * v[3]; }
        ss = wave_sum(ss);
        const float rstd = rsqrtf(ss * (1.0f / DM) + EPS);
#pragma unroll
        for (int i = 0; i < 4; ++i) { const f32x4 nw = *(const f32x4*)(w.norm2_w + c.lane * 4 + 256 * i);
#pragma unroll
            for (int j = 0; j < 4; ++j) x[4 * i + j] = x[4 * i + j] * rstd * nw[j];
            u32x2 pk; pk.x = pk2(x[4 * i], x[4 * i + 1]); pk.y = pk2(x[4 * i + 2], x[4 * i + 3]); *(u32x2*)(XN + (size_t)row * DM + c.lane * 4 + 256 * i) = pk; }
        float mylg = 0.f;
#pragma unroll 1
        for (int j = 0; j < 20; ++j) { float a = 0.f;
#pragma unroll
            for (int i = 0; i < 4; ++i) { const f32x4 wv = *(const LAS f32x4*)(WR + j * 1024 + c.lane * 4 + 256 * i); a += x[4 * i] * wv[0] + x[4 * i + 1] * wv[1] + x[4 * i + 2] * wv[2] + x[4 * i + 3] * wv[3]; }
            a = wave_sum(a); mylg = (c.lane == j) ? a : mylg; }
        float lg[20];
#pragma unroll
        for (int j = 0; j < 20; ++j) lg[j] = __int_as_float(__builtin_amdgcn_readlane(__float_as_int(mylg), j));
        if (c.lane == 0) {
            int g = 0; float gm = lg[0];
#pragma unroll
            for (int j = 1; j < 4; ++j) if (lg[j] > gm) { gm = lg[j]; g = j; }
            float den = 0.f;
#pragma unroll
            for (int j = 0; j < 4; ++j) den += __expf(lg[j] - gm);
            const float pg = 1.0f / den;
            float le[4];
#pragma unroll
            for (int j = 0; j < 4; ++j) le[j] = (g == 0) ? +lg[4 + j] : (g == 1) ? +lg[8 + j] : (g == 2) ? +lg[12 + j] : +lg[16 + j];
            int i1 = 0; float m1 = le[0];
#pragma unroll
            for (int j = 1; j < 4; ++j) if (le[j] > m1) { m1 = le[j]; i1 = j; }
            int i2 = -1; float m2 = -3.0e38f;
#pragma unroll
            for (int j = 0; j < 4; ++j) if (j != i1 && le[j] > m2) { m2 = le[j]; i2 = j; }
            const float w1 = pg / (1.0f + __expf(m2 - m1)), w2 = pg - w1;
            const int a = i1 < i2 ? +i1 : +i2, bq = i1 < i2 ? +i2 : +i1; const float wa = i1 < i2 ? +w1 : +w2, wb = i1 < i2 ? +w2 : +w1;
            const int pidx = (a == 0) ? (bq - 1) : (a == 1) ? (bq + 1) : 5;
            const int cls = g * 6 + pidx;
            const unsigned slot = atomicAdd(cnt + cls, 1u);
            LIST[(size_t)cls * T + slot] = row; WTS[((size_t)cls * T + slot) * 2] = wa; WTS[((size_t)cls * T + slot) * 2 + 1] = wb;
        }
    }
}
struct MoeTab { LAS int* cls; LAS int* til; LAS int* cntv; int ntiles; };
__device__ __forceinline__ MoeTab moe_table(const Ctx& c, int layer) {
    MoeTab mt; mt.cls = (LAS int*)(c.lds + MISC_OFF - 4096); mt.til = mt.cls + MAXCT; mt.cntv = mt.til + MAXCT;
    __syncthreads();
    if (c.tid == 0) { const unsigned* cnt = c.ctl + CW_CNT + layer * 32; int n = 0;
        for (int k = 0; k < NCLS; ++k) { const int cv = (int)__hip_atomic_load(cnt + k, __ATOMIC_RELAXED, __HIP_MEMORY_SCOPE_AGENT); mt.cntv[k] = cv; const int nt = (cv + 255) >> 8;
            for (int t = 0; t < nt && n < MAXCT; ++t) { mt.cls[n] = k; mt.til[n] = t; ++n; } }
        mt.cntv[NCLS] = n; }
    __syncthreads();
    mt.ntiles = __builtin_amdgcn_readfirstlane(mt.cntv[NCLS]);
    return mt;
}
__device__ __forceinline__ void cls_experts(int cls, int& ea, int& eb) { const int g = cls / 6, pi = cls - g * 6; const int a = pi < 3 ? 0 : (pi < 5 ? 1 : 2); const int b = pi < 3 ? pi + 1 : (pi < 5 ? pi - 1 : 3); ea = g * 4 + a; eb = g * 4 + b; }
__device__ __forceinline__ void gu_simple(const Ctx& c, const LayerW& w, int layer) {
    const MoeTab mt = moe_table(c, layer);
    const bf16_t* XN = (const bf16_t*)((unsigned char*)c.Z + MZ_XN); bf16_t* HID = (bf16_t*)((unsigned char*)c.Z + MZ_HID);
    const int* LIST = (const int*)((unsigned char*)c.Z + MZ_LIST); const float* WTS = (const float*)((unsigned char*)c.Z + MZ_WTS);
    const int nwt = mt.ntiles * 256;
    for (int t = c.wg * 8 + c.wave; t < nwt; t += c.G * 8) {
        const int ct = t >> 8, rem = t & 255, mi = rem >> 4, ni = rem & 15, sel = ni >> 3, hc0 = (ni & 7) * 64;
        const int cls = mt.cls[ct], til = mt.til[ct], valid = min(256, mt.cntv[cls] - 256 * til);
        int ea, eb; cls_experts(cls, ea, eb); const int e = sel ? eb : ea;
        const int* lst = LIST + (size_t)cls * T + 256 * til;
        const int ar = mi * 16 + (c.lane & 15); const int tok = lst[ar < valid ? ar : 0];
        f32x4 ag[4], au[4]; ZERO_ACC(ag); ZERO_ACC(au);
        const bf16_t* Bg = w.Bgu + (size_t)e * 1024 * 1024; const int brow = 256 * (hc0 >> 7) + (hc0 & 127);
        sg_acc(ag, XN + (size_t)tok * DM, Bg, DM, brow, DM, c.lane);
        sg_acc(au, XN + (size_t)tok * DM, Bg, DM, brow + 128, DM, c.lane);
#pragma unroll
        for (int r = 0; r < 4; ++r) { const int rr = mi * 16 + (c.lane >> 4) * 4 + r; const float wt = (rr < valid) ? WTS[((size_t)cls * T + 256 * til + rr) * 2 + sel] : 0.f;
#pragma unroll
            for (int j = 0; j < 4; ++j) { const int col = hc0 + 16 * j + (c.lane & 15); HID[((size_t)ct * 256 + rr) * 1024 + sel * 512 + col] = f2bf(siluf_(ag[j][r]) * au[j][r] * wt); } }
    }
}
__device__ __forceinline__ void dn_simple(const Ctx& c, const LayerW& w, int layer) {
    const MoeTab mt = moe_table(c, layer);
    const bf16_t* HID = (const bf16_t*)((unsigned char*)c.Z + MZ_HID); const int* LIST = (const int*)((unsigned char*)c.Z + MZ_LIST);
    const int nwt = mt.ntiles * 256;
    for (int t = c.wg * 8 + c.wave; t < nwt; t += c.G * 8) {
        const int ct = t >> 8, rem = t & 255, mi = rem >> 4, n0 = (rem & 15) * 64;
        const int cls = mt.cls[ct], til = mt.til[ct], valid = min(256, mt.cntv[cls] - 256 * til);
        int ea, eb; cls_experts(cls, ea, eb);
        f32x4 acc[4]; ZERO_ACC(acc);
        const bf16_t* ar = HID + ((size_t)ct * 256 + mi * 16 + (c.lane & 15)) * 1024;
        sg_acc(acc, ar, w.Bdn + (size_t)ea * 1024 * 512, 512, n0, 512, c.lane);
        sg_acc(acc, ar + 512, w.Bdn + (size_t)eb * 1024 * 512, 512, n0, 512, c.lane);
        const int* lst = LIST + (size_t)cls * T + 256 * til;
#pragma unroll
        for (int r = 0; r < 4; ++r) { const int rr = mi * 16 + (c.lane >> 4) * 4 + r; const bool ok = rr < valid; const int tok = ok ? lst[rr] : 0; float sq = 0.f;
#pragma unroll
            for (int j = 0; j < 4; ++j) { const int col = n0 + 16 * j + (c.lane & 15);
                if (ok) { const float hv = c.H[(size_t)tok * DM + col] + acc[j][r]; c.H[(size_t)tok * DM + col] = hv; c.HB[(size_t)tok * DM + col] = f2bf(hv); sq += hv * hv; } }
            sq += shx<1>(sq); sq += shx<2>(sq); sq += shx<4>(sq); sq += shx<8>(sq);
            if (ok && (c.lane & 15) == 0) c.SS[(size_t)tok * 16 + (n0 >> 6)] = sq; }
    }
}
__device__ __forceinline__ void final_phase(const Ctx& c) {
    const float* fw = inp(c, 18);
    for (int o = c.wg * 8 + c.wave; o < NB * SEQ; o += c.G * 8) {
        const int b = o >> 11, sidx = o & 2047, row = row_of(b, sidx + NMETA);
        const float rstd = rsqrtf(ss_row(c.SS, row) * (1.0f / DM) + EPS);
#pragma unroll
        for (int i = 0; i < 4; ++i) { const int col = c.lane * 4 + 256 * i; const f32x4 v = *(const f32x4*)(c.H + (size_t)row * DM + col), wv = *(const f32x4*)(fw + col);
            *(f32x4*)(c.out + (size_t)o * DM + col) = v * rstd * wv; }
    }
}
namespace og {
constexpr int BM = 256, BK = 64, HALF = 128, HTB = HALF * BK * 2, STAGE_BYTES = 8 * HTB;
__device__ __forceinline__ int lds_byte(int r, int c) { const int st = (r >> 4) * 2 + (c >> 5), rr = r & 15, cc = c & 31, ob = rr * 64 + cc * 2; return st * 1024 + (ob ^ (((ob >> 9) & 1) << 5)); }
__device__ __forceinline__ void stage_rc(int b, int& R, int& C) { const int st = b / 1024, sb = b % 1024, swz = sb ^ (((sb >> 9) & 1) << 5); R = (st >> 1) * 16 + swz / 64; C = (st & 1) * 32 + (swz % 64) / 2; }
__device__ __forceinline__ int perm32(int rho) { const int n = rho >> 4, i = rho & 15; return 8 * (i >> 2) + 4 * n + (i & 3); }
__device__ __forceinline__ unsigned cvt_pk_bf16(float lo, float hi) { unsigned r; asm volatile("v_cvt_pk_bf16_f32 %0, %1, %2" : "=v"(r) : "v"(lo), "v"(hi)); return r; }

struct UD { const char* A; const char* B; const int* gl; int gvalid; int mid; int p0, p1, p2, p3; };

typedef f32x4 Acc[2][2][4][2];

template <class Epi, class Sched, bool GATHER>
__device__ __forceinline__ void gemm_run(LAS unsigned char* lds, const Sched& S, const Epi& E, const unsigned lda, const unsigned ldb, const int nt) {
    int tid = threadIdx.x; asm volatile("" : "+v"(tid));
    const int wid = __builtin_amdgcn_readfirstlane(tid >> 6), lane = tid & 63, wr = wid >> 2, wc = wid & 3, fr = lane & 15, fq = lane >> 4;
    unsigned voffB[2];
#pragma unroll
    for (int i = 0; i < 2; ++i) { int R, C; stage_rc(tid * 16 + i * 8192, R, C); const int Rb = (R & ~31) + perm32(R & 31); voffB[i] = (unsigned)Rb * ldb + (unsigned)C * 2u; }
    const size_t kstep = (size_t)(BK * 2);
    const size_t hstepB = (size_t)HALF * ldb;
    const size_t hstepA = GATHER ? (size_t)0 : (size_t)HALF * lda;
    const unsigned ldsw = (unsigned)wid * 1024u;
    const int aoff = lds_byte(wr * 64 + fr, fq * 8), boff = lds_byte(wc * 32 + fr, fq * 8);
#define OG_SA(b, h) (((b) * 2 + (h)) * HTB)
#define OG_SB(b, h) ((4 + (b) * 2 + (h)) * HTB)
#define OG_STAGE(bufoff, gbase, voff) do { _Pragma("unroll") for (int _i = 0; _i < 2; ++_i) \
        __builtin_amdgcn_global_load_lds((const unsigned*)((const char*)(gbase) + (voff)[_i]), (LAS unsigned*)(lds + (bufoff) + ldsw + _i * 8192), 16, 0, 0); } while (0)
#define OG_LDA(dst, b, h) do { _Pragma("unroll") for (int m = 0; m < 4; ++m) _Pragma("unroll") for (int k = 0; k < 2; ++k) dst[m][k] = *(const LAS bf16x8*)(lds + OG_SA(b, h) + aoff + m * 2048 + k * 1024); } while (0)
#define OG_LDB(dst, b, h) do { _Pragma("unroll") for (int n = 0; n < 2; ++n) _Pragma("unroll") for (int k = 0; k < 2; ++k) dst[n][k] = *(const LAS bf16x8*)(lds + OG_SB(b, h) + boff + n * 2048 + k * 1024); } while (0)
#define OG_MMA(ai, bj, At, Bt) do { __builtin_amdgcn_s_setprio(1); _Pragma("unroll") for (int m = 0; m < 4; ++m) _Pragma("unroll") for (int n = 0; n < 2; ++n) _Pragma("unroll") for (int k = 0; k < 2; ++k) \
        acc[ai][bj][m][n] = __builtin_amdgcn_mfma_f32_16x16x32_bf16(Bt[n][k], At[m][k], acc[ai][bj][m][n], 0, 0, 0); __builtin_amdgcn_s_setprio(0); } while (0)
#define OG_WAIT_V(n) asm volatile("s_waitcnt vmcnt(" #n ")" ::: "memory")
#define OG_WAIT_L(n) asm volatile("s_waitcnt lgkmcnt(" #n ")" ::: "memory")
#define OG_BAR __builtin_amdgcn_s_barrier()
#define OG_SCHED __builtin_amdgcn_sched_barrier(0)
#define OG_SETOFF(dst, u) do { int _t = threadIdx.x; asm volatile("" : "+v"(_t)); _Pragma("unroll") for (int _i = 0; _i < 2; ++_i) { int _R, _C; stage_rc(_t * 16 + _i * 8192, _R, _C); \
        _Pragma("unroll") for (int _h = 0; _h < 2; ++_h) { const int _r = _h * HALF + _R; \
        int _row = _r; if (GATHER) _row = (u).gl[_r < (u).gvalid ? _r : 0]; dst[_h][_i] = (unsigned)_row * lda + (unsigned)_C * 2u; } } } while (0)
    UD cur, nxt; int ui = 0;
    if (!S.get(0, cur)) return;
    Acc acc;
    { float z0 = 0.f; asm volatile("" : "+v"(z0));
#pragma unroll
    for (int a = 0; a < 2; ++a)
#pragma unroll
        for (int b = 0; b < 2; ++b)
#pragma unroll
            for (int m = 0; m < 4; ++m)
#pragma unroll
                for (int n = 0; n < 2; ++n) acc[a][b][m][n] = (f32x4){z0, z0, z0, z0}; }
    bf16x8 At[4][2], B0[2][2], B1[2][2];
    unsigned oA[2][2], oN[2][2];
    OG_SETOFF(oA, cur);
    const char* cA = cur.A; const char* cB = cur.B;
    OG_STAGE(OG_SB(0, 0), cB, voffB); OG_STAGE(OG_SB(0, 1), cB + hstepB, voffB); OG_STAGE(OG_SA(0, 0), cA, oA[0]); OG_STAGE(OG_SA(0, 1), cA + hstepA, oA[GATHER ? 1 : 0]);
    if (wr == 1) OG_BAR;
    OG_WAIT_V(2); OG_BAR;
    OG_STAGE(OG_SB(1, 0), cB + kstep, voffB); OG_STAGE(OG_SA(1, 0), cA + kstep, oA[0]); OG_STAGE(OG_SB(1, 1), cB + hstepB + kstep, voffB);
    OG_WAIT_V(6); OG_BAR;
    for (;;) {
        const bool has_next = S.get(ui + 1, nxt);
        const char* nA = has_next ? nxt.A : cA; const char* nB = has_next ? nxt.B : cB;
        if (GATHER) { if (has_next) { OG_SETOFF(oN, nxt); } else {
#pragma unroll
            for (int h = 0; h < 2; ++h)
#pragma unroll
                for (int i = 0; i < 2; ++i) oN[h][i] = oA[h][i]; } }
#pragma unroll 1
        for (int t = 0; t < nt; t += 2) {
            const bool last = (t == nt - 2);
            const char* a1 = cA + (size_t)(t + 1) * kstep;
            const char* a2 = last ? nA : cA + (size_t)(t + 2) * kstep; const char* b2 = last ? nB : cB + (size_t)(t + 2) * kstep;
            const char* a3 = a2 + kstep; const char* b3 = b2 + kstep;
            unsigned o2[2][2];
#pragma unroll
            for (int h = 0; h < 2; ++h)
#pragma unroll
                for (int i = 0; i < 2; ++i) o2[h][i] = (GATHER && last) ? oN[h][i] : oA[h][i];
            OG_LDB(B0, 0, 0); OG_LDB(B1, 0, 1); OG_SCHED; OG_LDA(At, 0, 0); OG_STAGE(OG_SA(1, 1), a1 + hstepA, oA[GATHER ? 1 : 0]);
            OG_WAIT_V(8); OG_WAIT_L(0); OG_BAR; OG_MMA(0, 0, At, B0); OG_MMA(0, 1, At, B1); OG_BAR; OG_SCHED;
            OG_LDA(At, 0, 1); OG_STAGE(OG_SB(0, 0), b2, voffB); OG_STAGE(OG_SB(0, 1), b2 + hstepB, voffB); OG_STAGE(OG_SA(0, 0), a2, o2[0]);
            OG_WAIT_V(8); OG_WAIT_L(0); OG_BAR; OG_MMA(1, 0, At, B0); OG_MMA(1, 1, At, B1); OG_BAR; OG_SCHED;
            OG_LDB(B0, 1, 0); OG_LDB(B1, 1, 1); OG_SCHED; OG_LDA(At, 1, 0); OG_STAGE(OG_SA(0, 1), a2 + hstepA, o2[GATHER ? 1 : 0]);
            OG_WAIT_V(8); OG_WAIT_L(0); OG_BAR; OG_MMA(0, 0, At, B0); OG_MMA(0, 1, At, B1); OG_BAR; OG_SCHED;
            OG_LDA(At, 1, 1); OG_STAGE(OG_SB(1, 0), b3, voffB); OG_STAGE(OG_SB(1, 1), b3 + hstepB, voffB); OG_STAGE(OG_SA(1, 0), a3, o2[0]);
            OG_WAIT_V(8); OG_WAIT_L(0); OG_BAR; OG_MMA(1, 0, At, B0); OG_MMA(1, 1, At, B1); OG_BAR; OG_SCHED;
        }
        if (wr == 0) OG_BAR;
        { int t2 = threadIdx.x; asm volatile("" : "+v"(t2));
          const int w2 = __builtin_amdgcn_readfirstlane(t2 >> 6), wr2 = w2 >> 2, wc2 = w2 & 3, fr2 = t2 & 15, fq2 = (t2 >> 4) & 3;
          if constexpr (Epi::UNIFIED) { E.uni(acc, cur, wr2, wc2, fr2, fq2); }
          else { if (cur.mid) { E.mid(acc, cur, wr2, wc2, fr2, fq2); } else { E(acc, cur, wr2, wc2, fr2, fq2); } } }
        if (!has_next) break;
        if (!cur.mid) { float z0 = 0.f; asm volatile("" : "+v"(z0));
#pragma unroll
            for (int a = 0; a < 2; ++a)
#pragma unroll
                for (int b = 0; b < 2; ++b)
#pragma unroll
                    for (int m = 0; m < 4; ++m)
#pragma unroll
                        for (int n = 0; n < 2; ++n) acc[a][b][m][n] = (f32x4){z0, z0, z0, z0};
        }
        cur = nxt; cA = nA; cB = nB; ++ui;
        if (GATHER) {
#pragma unroll
            for (int h = 0; h < 2; ++h)
#pragma unroll
                for (int i = 0; i < 2; ++i) oA[h][i] = oN[h][i]; }
        if (wr == 1) OG_BAR;
    }
    OG_WAIT_V(0);
    OG_BAR;
#undef OG_SA
#undef OG_SB
#undef OG_STAGE
#undef OG_LDA
#undef OG_LDB
#undef OG_MMA
#undef OG_WAIT_V
#undef OG_WAIT_L
#undef OG_BAR
#undef OG_SCHED
#undef OG_SETOFF
}

__device__ __forceinline__ void grid_tile(int L, int nM, int nN, int& pm, int& pn) {
    const int nwg = nM * nN; int wgid = L; { const int q = nwg / 8, r = nwg % 8, xcd = wgid % 8, off = wgid / 8; wgid = (xcd < r ? xcd * (q + 1) : r * (q + 1) + (xcd - r) * q) + off; }
    const int nig = 8 * nN, gid = wgid / nig, fm = gid * 8, gsz = (nM - fm) < 8 ? (nM - fm) : 8;
    pm = fm + ((wgid % nig) % gsz); pn = (wgid % nig) / gsz;
}
#define OG_ROWS for (int ai = 0; ai < 2; ++ai) _Pragma("unroll") for (int m = 0; m < 4; ++m)
__device__ __forceinline__ int og_row(int cst, int base) { int v = cst; asm volatile("" : "+v"(v)); return v + base; }
#define OG_ROW og_row(ai * 128 + m * 16, wr * 64 + fr)
#define OG_COL(bj) ((bj) * 128 + wc * 32 + fq * 8)
__device__ __forceinline__ void unpack8(const u32x4 v, float (&f)[8]) {
#pragma unroll
    for (int j = 0; j < 4; ++j) { f[2 * j] = __uint_as_float(v[j] << 16); f[2 * j + 1] = __uint_as_float(v[j] & 0xffff0000u); } }
__device__ __forceinline__ u32x4 pack8(const f32x4 a, const f32x4 b) { u32x4 w; w.x = cvt_pk_bf16(a[0], a[1]); w.y = cvt_pk_bf16(a[2], a[3]); w.z = cvt_pk_bf16(b[0], b[1]); w.w = cvt_pk_bf16(b[2], b[3]); return w; }

struct SchedP1 { const char* A; const char* B; int nM, G, wg;
    __device__ __forceinline__ bool get(int i, UD& u) const { const int L = i * G + wg; if (L >= nM * 26) return false; int pm, pn; grid_tile(L, nM, 26, pm, pn);
        u.A = A + (size_t)pm * 256 * 2048; u.B = B + (size_t)pn * 256 * 2048; u.gl = nullptr; u.gvalid = 0; u.mid = 0; u.p0 = pm; u.p1 = pn; u.p2 = 0; u.p3 = 0; return true; } };
struct EpiP1 { static constexpr bool UNIFIED = false; bf16_t* Z; const float* SS; const float* b_gate;
    __device__ __forceinline__ void mid(Acc&, const UD&, int, int, int, int) const {}
    __device__ __forceinline__ void operator()(const Acc& acc, const UD& u, int wr, int wc, int fr, int fq) const {
        const int pm = u.p0, pn = u.p1; const int kind = (pn < 8) ? 0 : (pn < 12) ? 1 : (pn < 14) ? 2 : (pn < 18) ? 0 : 3;
        float bg[2][8];
#pragma unroll
        for (int bj = 0; bj < 2; ++bj)
#pragma unroll
            for (int j = 0; j < 8; ++j) bg[bj][j] = 0.f;
        if (kind == 2) {
#pragma unroll
            for (int bj = 0; bj < 2; ++bj) { const float* bp = b_gate + (pn - 12) * 256 + OG_COL(bj); const f32x4 x0 = *(const f32x4*)bp, x1 = *(const f32x4*)(bp + 4);
#pragma unroll
                for (int j = 0; j < 4; ++j) { bg[bj][j] = x0[j]; bg[bj][4 + j] = x1[j]; } } }
#pragma unroll
        OG_ROWS { const int row = pm * 256 + OG_ROW;
            float ssum; { const f32x4 pv = *(const f32x4*)(SS + (size_t)row * 16 + 4 * fq); ssum = (pv[0] + pv[1]) + (pv[2] + pv[3]); ssum += shx<16>(ssum); ssum = xsum32(ssum); }
            const float rstd = rsqrtf(ssum * (1.0f / DM) + EPS);
#pragma unroll
            for (int bj = 0; bj < 2; ++bj) { f32x4 v0 = acc[ai][bj][m][0] * rstd, v1 = acc[ai][bj][m][1] * rstd;
                if (kind == 1) {
#pragma unroll
                    for (int j = 0; j < 4; ++j) { v0[j] = siluf_(v0[j]); v1[j] = siluf_(v1[j]); } }
                else if (kind == 2) {
#pragma unroll
                    for (int j = 0; j < 4; ++j) { v0[j] = logsigmoidf_(v0[j] + bg[bj][j]) * 0.0625f; v1[j] = logsigmoidf_(v1[j] + bg[bj][4 + j]) * 0.0625f; } }
                else if (kind == 3) {
#pragma unroll
                    for (int j = 0; j < 4; ++j) { v0[j] = sigmoidf_(v0[j]); v1[j] = sigmoidf_(v1[j]); } }
                *(u32x4*)(Z + (size_t)row * ZC + pn * 256 + OG_COL(bj)) = pack8(v0, v1); } }
    } };
struct SchedP3 { const char* A; const char* B; int nM, G, wg;
    __device__ __forceinline__ bool get(int i, UD& u) const { const int L = i * G + wg; if (L >= nM * 4) return false; int pm, pn; grid_tile(L, nM, 4, pm, pn);
        u.A = A + (size_t)pm * 256 * 2048 + pn * 512; u.B = B + (size_t)pn * 131072; u.gl = nullptr; u.gvalid = 0; u.mid = 0; u.p0 = pm; u.p1 = pn; u.p2 = 0; u.p3 = 0; return true; } };
struct EpiP3 { static constexpr bool UNIFIED = false; bf16_t* Z; const float* scale;
    __device__ __forceinline__ void mid(Acc&, const UD&, int, int, int, int) const {}
    __device__ __forceinline__ void operator()(const Acc& acc, const UD& u, int wr, int wc, int fr, int fq) const {
        const int pm = u.p0, pn = u.p1; f32x4 sc[2][2];
#pragma unroll
        for (int bj = 0; bj < 2; ++bj) { const float* sp = scale + pn * 256 + OG_COL(bj); sc[bj][0] = *(const f32x4*)sp; sc[bj][1] = *(const f32x4*)(sp + 4); }
#pragma unroll
        OG_ROWS { const int row = pm * 256 + OG_ROW;
#pragma unroll
            for (int bj = 0; bj < 2; ++bj) *(u32x4*)(Z + (size_t)row * ZC + ZQ + pn * 256 + OG_COL(bj)) = pack8(acc[ai][bj][m][0] * sc[bj][0], acc[ai][bj][m][1] * sc[bj][1]); }
    } };
struct SchedP4 { const char* Z; const char* Bg; const char* Bp; int nM, G, wg;
    __device__ __forceinline__ bool get(int i, UD& u) const { const int L = (i >> 1) * G + wg; if (L >= nM * 4) return false; int pm, pn; grid_tile(L, nM, 4, pm, pn); const int part = i & 1;
        u.A = Z + (size_t)pm * 256 * (ZC * 2) + (part ? ZQ * 2 : ZOG * 2); u.B = (part ? Bp : Bg) + (size_t)pn * 256 * 2048; u.gl = nullptr; u.gvalid = 0; u.mid = part ? 0 : 1; u.p0 = pm; u.p1 = pn; u.p2 = 0; u.p3 = 0; return true; } };
struct EpiP4 { static constexpr bool UNIFIED = true; bf16_t* Z;
    __device__ __forceinline__ void uni(Acc& acc, const UD& u, int wr, int wc, int fr, int fq) const {
        const int pm = u.p0, pn = u.p1; const bool mid = u.mid != 0;
#pragma unroll
        OG_ROWS { const int row = pm * 256 + OG_ROW;
#pragma unroll
            for (int bj = 0; bj < 2; ++bj) { bf16_t* zp = Z + (size_t)row * ZC + pn * 256 + OG_COL(bj); float g0[8], g1[8]; unpack8(*(const u32x4*)(zp + ZG0), g0); unpack8(*(const u32x4*)(zp + ZG1), g1);
                f32x4 v0, v1;
#pragma unroll
                for (int j = 0; j < 4; ++j) { const float a = fmaxf(g1[j], 1e-30f), b = fmaxf(g1[4 + j], 1e-30f);
                    const float fa = mid ? g0[j] * __builtin_amdgcn_rcpf(a) : a, fb = mid ? g0[4 + j] * __builtin_amdgcn_rcpf(b) : b;
                    v0[j] = acc[ai][bj][m][0][j] * fa; v1[j] = acc[ai][bj][m][1][j] * fb; }
                acc[ai][bj][m][0] = v0; acc[ai][bj][m][1] = v1;
                if (!mid) *(u32x4*)(zp + ZV) = pack8(v0, v1); }
            asm volatile("" ::: "memory"); }
    } };
struct SchedP5 { const char* Z; const char* B; int nM, G, wg;
    __device__ __forceinline__ bool get(int i, UD& u) const { const int L = i * G + wg; if (L >= nM * 4) return false; int pm, pn; grid_tile(L, nM, 4, pm, pn);
        u.A = Z + (size_t)pm * 256 * (ZC * 2) + ZV * 2; u.B = B + (size_t)pn * 256 * 2048; u.gl = nullptr; u.gvalid = 0; u.mid = 0; u.p0 = pm; u.p1 = pn; u.p2 = 0; u.p3 = 0; return true; } };
struct EpiP5 { static constexpr bool UNIFIED = false; float* H;
    __device__ __forceinline__ void mid(Acc&, const UD&, int, int, int, int) const {}
    __device__ __forceinline__ void operator()(const Acc& acc, const UD& u, int wr, int wc, int fr, int fq) const {
        const int pm = u.p0, pn = u.p1;
#pragma unroll
        OG_ROWS { const int row = pm * 256 + OG_ROW;
#pragma unroll
            for (int bj = 0; bj < 2; ++bj) { float* hp = H + (size_t)row * DM + pn * 256 + OG_COL(bj); const f32x4 h0 = *(const f32x4*)hp, h1 = *(const f32x4*)(hp + 4);
                *(f32x4*)hp = h0 + acc[ai][bj][m][0]; *(f32x4*)(hp + 4) = h1 + acc[ai][bj][m][1]; }
            asm volatile("" ::: "memory"); }
    } };
struct SchedGU { const char* XN; const char* Bgu; const int* LIST; MoeTab mt; int G, wg;
    __device__ __forceinline__ bool get(int i, UD& u) const { const int L = i * G + wg; if (L >= mt.ntiles * 8) return false; const int ct = L >> 3, sel = (L >> 2) & 1, pn = L & 3;
        const int cls = __builtin_amdgcn_readfirstlane(mt.cls[ct]), til = __builtin_amdgcn_readfirstlane(mt.til[ct]), cnt = __builtin_amdgcn_readfirstlane(mt.cntv[cls]); int ea, eb; cls_experts(cls, ea, eb); const int e = sel ? eb : ea;
        u.A = XN; u.B = Bgu + (size_t)e * 2097152 + (size_t)pn * 256 * 2048; u.gl = LIST + (size_t)cls * T + 256 * til; u.gvalid = min(256, cnt - 256 * til); u.mid = 0;
        u.p0 = ct; u.p1 = pn; u.p2 = sel; u.p3 = cls * T + 256 * til; return true; } };
struct EpiGU { static constexpr bool UNIFIED = false; bf16_t* HID; const float* WTS;
    __device__ __forceinline__ void mid(Acc&, const UD&, int, int, int, int) const {}
    __device__ __forceinline__ void operator()(const Acc& acc, const UD& u, int wr, int wc, int fr, int fq) const {
        const int ct = u.p0, pn = u.p1, sel = u.p2;
#pragma unroll
        OG_ROWS { const int r = OG_ROW; const float wt = (r < u.gvalid) ? WTS[((size_t)u.p3 + r) * 2 + sel] : 0.f; f32x4 v0, v1;
#pragma unroll
            for (int j = 0; j < 4; ++j) { v0[j] = siluf_(acc[ai][0][m][0][j]) * acc[ai][1][m][0][j] * wt; v1[j] = siluf_(acc[ai][0][m][1][j]) * acc[ai][1][m][1][j] * wt; }
            *(u32x4*)(HID + ((size_t)ct * 256 + r) * 1024 + sel * 512 + pn * 128 + wc * 32 + fq * 8) = pack8(v0, v1); }
    } };
struct SchedDN { const char* HID; const char* Bdn; const int* LIST; MoeTab mt; int G, wg;
    __device__ __forceinline__ bool get(int i, UD& u) const { const int L = (i >> 1) * G + wg; if (L >= mt.ntiles * 4) return false; const int ct = L >> 2, pn = L & 3, part = i & 1;
        const int cls = __builtin_amdgcn_readfirstlane(mt.cls[ct]), til = __builtin_amdgcn_readfirstlane(mt.til[ct]), cnt = __builtin_amdgcn_readfirstlane(mt.cntv[cls]); int ea, eb; cls_experts(cls, ea, eb); const int e = part ? eb : ea;
        u.A = HID + (size_t)ct * 256 * 2048 + part * 1024; u.B = Bdn + (size_t)e * 1048576 + (size_t)pn * 256 * 1024; u.gl = LIST + (size_t)cls * T + 256 * til; u.gvalid = min(256, cnt - 256 * til); u.mid = part ? 0 : 1;
        u.p0 = ct; u.p1 = pn; u.p2 = 0; u.p3 = 0; return true; } };
struct EpiDN { static constexpr bool UNIFIED = false; float* H; bf16_t* HB; float* SS;
    __device__ __forceinline__ void mid(Acc&, const UD&, int, int, int, int) const {}
    __device__ __forceinline__ void operator()(const Acc& acc, const UD& u, int wr, int wc, int fr, int fq) const {
        const int pn = u.p1;
#pragma unroll
        OG_ROWS { const int r = OG_ROW; const bool ok = r < u.gvalid; const int tok = ok ? u.gl[r] : 0; float sq = 0.f;
            if (ok) {
#pragma unroll
                for (int bj = 0; bj < 2; ++bj) { const size_t off = (size_t)tok * DM + pn * 256 + OG_COL(bj); const f32x4 h0 = *(const f32x4*)(H + off) + acc[ai][bj][m][0], h1 = *(const f32x4*)(H + off + 4) + acc[ai][bj][m][1];
                    *(f32x4*)(H + off) = h0; *(f32x4*)(H + off + 4) = h1; *(u32x4*)(HB + off) = pack8(h0, h1);
                    sq += h0[0] * h0[0] + h0[1] * h0[1] + h0[2] * h0[2] + h0[3] * h0[3] + h1[0] * h1[0] + h1[1] * h1[1] + h1[2] * h1[2] + h1[3] * h1[3]; } }
            sq += shx<16>(sq); sq = xsum32(sq);
            if (ok && fq == 0) SS[(size_t)tok * 16 + pn * 4 + wc] = sq;
            asm volatile("" ::: "memory"); }
    } };
}

__device__ __forceinline__ void p1_opt(const Ctx& c, const LayerW& w, int segbase, int segrows) {
    og::SchedP1 S{(const char*)(c.HB + (size_t)segbase * DM), (const char*)w.Bin, segrows / 256, c.G, c.wg}; og::EpiP1 E{c.Z, c.SS + (size_t)segbase * 16, w.b_gate};
    og::gemm_run<og::EpiP1, og::SchedP1, false>(c.lds, S, E, 2048u, 2048u, 16);
}
__device__ __forceinline__ void p3_opt(const Ctx& c, const LayerW& w, int segbase, int segrows) {
    og::SchedP3 S{(const char*)(c.HB + (size_t)segbase * DM), (const char*)w.Bgrp, segrows / 256, c.G, c.wg}; og::EpiP3 E{c.Z, w.pool_scale};
    og::gemm_run<og::EpiP3, og::SchedP3, false>(c.lds, S, E, 2048u, 512u, 4);
}
__device__ __forceinline__ void p4_opt(const Ctx& c, const LayerW& w, int segrows) {
    og::SchedP4 S{(const char*)c.Z, (const char*)w.Bbrg, (const char*)w.Bbrp, segrows / 256, c.G, c.wg}; og::EpiP4 E{c.Z};
    og::gemm_run<og::EpiP4, og::SchedP4, false>(c.lds, S, E, (unsigned)(ZC * 2), 2048u, 16);
}
__device__ __forceinline__ void p5_opt(const Ctx& c, const LayerW& w, int segbase, int segrows) {
    og::SchedP5 S{(const char*)c.Z, (const char*)w.Bout, segrows / 256, c.G, c.wg}; og::EpiP5 E{c.H + (size_t)segbase * DM};
    og::gemm_run<og::EpiP5, og::SchedP5, false>(c.lds, S, E, (unsigned)(ZC * 2), 2048u, 16);
}
__device__ __forceinline__ void gu_opt(const Ctx& c, const LayerW& w, int layer) {
    const MoeTab mt = moe_table(c, layer);
    og::SchedGU S{(const char*)c.Z + MZ_XN, (const char*)w.Bgu, (const int*)((const unsigned char*)c.Z + MZ_LIST), mt, c.G, c.wg};
    og::EpiGU E{(bf16_t*)((unsigned char*)c.Z + MZ_HID), (const float*)((const unsigned char*)c.Z + MZ_WTS)};
    og::gemm_run<og::EpiGU, og::SchedGU, true>(c.lds, S, E, 2048u, 2048u, 16);
}
__device__ __forceinline__ void dn_opt(const Ctx& c, const LayerW& w, int layer) {
    const MoeTab mt = moe_table(c, layer);
    og::SchedDN S{(const char*)c.Z + MZ_HID, (const char*)w.Bdn, (const int*)((const unsigned char*)c.Z + MZ_LIST), mt, c.G, c.wg};
    og::EpiDN E{c.H, c.HB, c.SS};
    og::gemm_run<og::EpiDN, og::SchedDN, false>(c.lds, S, E, 2048u, 1024u, 8);
}
__device__ __forceinline__ void chunk_rows(int seg, int b, int ch, int& r0, int& nvalid) {
    if (seg == 0) { if (ch == 0) { r0 = b * SEG0_LEN; nvalid = 16; } else { r0 = b * SEG0_LEN + 16 + 64 * (ch - 1); nvalid = 64; } }
    else { r0 = b * SEG1_LEN + 64 * (ch - 17); nvalid = 64; }
}
__device__ __forceinline__ float bflo(unsigned u) { return __uint_as_float(u << 16); }
__device__ __forceinline__ float bfhi(unsigned u) { return __uint_as_float(u & 0xffff0000u); }
__device__ __forceinline__ void gla_opt(const Ctx& c, int seg) {
    constexpr int STQ = 272, STT = 144;
    LAS unsigned char* const L = c.lds;
    LAS unsigned char* const QE = L; LAS unsigned char* const QI = L + 17408; LAS unsigned char* const KE = L + 34816; LAS unsigned char* const KI = L + 52224;
    LAS unsigned char* const KDT = L + 69632; LAS unsigned char* const VT = L + 88064; LAS unsigned char* const ATT = L + 97280;
    LAS float* const PART = (LAS float*)(L + 106496); LAS float* const EG = (LAS float*)(L + 110592); LAS unsigned char* const OP = L + 111104;
    const int lane = c.lane, w = c.wave, fr = lane & 15, g = lane >> 4, vt = w & 3, chh = w >> 2;
    const float LOG2E = 1.4426950408889634f;
    float* stsave = (float*)(c.ws + WS_STATE);
    for (int chain = c.wg; chain < 256; chain += c.G) {
        const int b = chain >> 4, h = (chain >> 2) & 3, s = chain & 3;
        f32x4 S0, S1, S2, S3;
        if (seg == 0) { S0 = (f32x4){0.f, 0.f, 0.f, 0.f}; S1 = S0; S2 = S0; S3 = S0; }
        else { const f32x4* sp = (const f32x4*)(stsave + ((size_t)chain * 512 + c.tid) * 16); S0 = sp[0]; S1 = sp[1]; S2 = sp[2]; S3 = sp[3]; }
        const int c_lo = seg == 0 ? 0 : 17, c_hi = seg == 0 ? 17 : 33;
        unsigned q2[8], k2[8], g2[8]; u32x4 vraw;
#define GLA_LOAD(chk) do { int r0_, nv_; chunk_rows(seg, b, (chk), r0_, nv_); const bf16_t* zr_ = c.Z + (size_t)r0_ * ZC; \
        _Pragma("unroll") for (int i = 0; i < 8; ++i) { const int row_ = 8 * w + i; const bool ok_ = row_ < nv_; const bf16_t* p_ = zr_ + (size_t)row_ * ZC + h * 128 + 2 * lane; \
            q2[i] = ok_ ? *(const unsigned*)(p_ + ZQ) : 0u; k2[i] = ok_ ? *(const unsigned*)(p_ + ZK) : 0u; g2[i] = ok_ ? *(const unsigned*)(p_ + ZG) : 0u; } \
        vraw = (lane < nv_) ? *(const u32x4*)(zr_ + (size_t)lane * ZC + ZV + h * 256 + s * 64 + 8 * w) : (u32x4){0u, 0u, 0u, 0u}; } while (0)
        GLA_LOAD(c_lo);
        for (int chk = c_lo; chk < c_hi; ++chk) {
            int r0, nvalid; chunk_rows(seg, b, chk, r0, nvalid);
            float cl0[8], cl1[8]; { float a0 = 0.f, a1 = 0.f;
#pragma unroll
                for (int i = 0; i < 8; ++i) { a0 += bflo(g2[i]); a1 += bfhi(g2[i]); cl0[i] = a0; cl1[i] = a1; }
                *(LAS f32x2*)(PART + w * 128 + 2 * lane) = (f32x2){a0, a1}; }
            __syncthreads();
            float p0 = 0.f, p1 = 0.f, t0 = 0.f, t1 = 0.f;
#pragma unroll
            for (int r = 0; r < 8; ++r) { const f32x2 x = *(const LAS f32x2*)(PART + r * 128 + 2 * lane); t0 += x[0]; t1 += x[1]; if (r < w) { p0 += x[0]; p1 += x[1]; } }
            const float eg0 = __builtin_amdgcn_exp2f(t0 * LOG2E), eg1 = __builtin_amdgcn_exp2f(t1 * LOG2E);
            if (w == 0) *(LAS f32x2*)(EG + 2 * lane) = (f32x2){eg0, eg1};
            unsigned kd0[4], kd1[4];
#pragma unroll
            for (int i = 0; i < 8; ++i) {
                const float b0 = (p0 + cl0[i]) * LOG2E, b1 = (p1 + cl1[i]) * LOG2E;
                const float e0 = __builtin_amdgcn_exp2f(b0), e1 = __builtin_amdgcn_exp2f(b1), ie0 = __builtin_amdgcn_exp2f(-b0), ie1 = __builtin_amdgcn_exp2f(-b1);
                const float qa = bflo(q2[i]), qb = bfhi(q2[i]), ka = bflo(k2[i]), kb = bfhi(k2[i]);
                const int ro = (8 * w + i) * STQ + 4 * lane;
                *(LAS unsigned*)(QE + ro) = og::cvt_pk_bf16(qa * e0, qb * e1); *(LAS unsigned*)(QI + ro) = og::cvt_pk_bf16(qa * ie0, qb * ie1);
                *(LAS unsigned*)(KE + ro) = og::cvt_pk_bf16(ka * e0, kb * e1); *(LAS unsigned*)(KI + ro) = og::cvt_pk_bf16(ka * ie0, kb * ie1);
                const float d0 = ka * ie0 * eg0, d1 = kb * ie1 * eg1;
                if (i & 1) { kd0[i >> 1] |= ((unsigned)f2bf(d0)) << 16; kd1[i >> 1] |= ((unsigned)f2bf(d1)) << 16; } else { kd0[i >> 1] = f2bf(d0); kd1[i >> 1] = f2bf(d1); }
            }
            *(LAS u32x4*)(KDT + (2 * lane) * STT + w * 16) = (u32x4){kd0[0], kd0[1], kd0[2], kd0[3]};
            *(LAS u32x4*)(KDT + (2 * lane + 1) * STT + w * 16) = (u32x4){kd1[0], kd1[1], kd1[2], kd1[3]};
#pragma unroll
            for (int j = 0; j < 4; ++j) { *(LAS bf16_t*)(VT + (8 * w + 2 * j) * STT + 2 * lane) = (bf16_t)(vraw[j] & 0xffffu); *(LAS bf16_t*)(VT + (8 * w + 2 * j + 1) * STT + 2 * lane) = (bf16_t)(vraw[j] >> 16); }
            if (chk + 1 < c_hi) { GLA_LOAD(chk + 1); }
            __syncthreads();
            { const int it = w >> 1;
#pragma unroll
              for (int tj = 0; tj < 2; ++tj) { const int jt = 2 * (w & 1) + tj;
                f32x4 lo = (f32x4){0.f, 0.f, 0.f, 0.f}, up = lo;
                if (it >= jt) {
#pragma unroll
                    for (int kb = 0; kb < 4; ++kb) { const bf16x8 a = *(const LAS bf16x8*)(QE + (16 * it + fr) * STQ + (32 * kb + 8 * g) * 2), bb = *(const LAS bf16x8*)(KI + (16 * jt + fr) * STQ + (32 * kb + 8 * g) * 2);
                        lo = __builtin_amdgcn_mfma_f32_16x16x32_bf16(a, bb, lo, 0, 0, 0); } }
                if (it <= jt) {
#pragma unroll
                    for (int kb = 0; kb < 4; ++kb) { const bf16x8 a = *(const LAS bf16x8*)(QI + (16 * it + fr) * STQ + (32 * kb + 8 * g) * 2), bb = *(const LAS bf16x8*)(KE + (16 * jt + fr) * STQ + (32 * kb + 8 * g) * 2);
                        up = __builtin_amdgcn_mfma_f32_16x16x32_bf16(a, bb, up, 0, 0, 0); } }
#pragma unroll
                for (int r = 0; r < 4; ++r) { const int il = 4 * g + r; float v = (it > jt) ? lo[r] : (it < jt) ? up[r] : ((il >= fr) ? lo[r] : up[r]);
                    *(LAS bf16_t*)(ATT + (16 * it + il) * STT + (16 * jt + fr) * 2) = f2bf(v); } } }
            f32x4 o0 = (f32x4){0.f, 0.f, 0.f, 0.f}, o1 = o0, o2 = o0, o3 = o0;
#pragma unroll
            for (int kbl = 0; kbl < 2; ++kbl) {
                const f32x4 sa = kbl ? S2 : S0, sb = kbl ? S3 : S1;
                const u32x4 bw = (u32x4){og::cvt_pk_bf16(sa[0], sa[1]), og::cvt_pk_bf16(sa[2], sa[3]), og::cvt_pk_bf16(sb[0], sb[1]), og::cvt_pk_bf16(sb[2], sb[3])};
                bf16x8 bfr; __builtin_memcpy(&bfr, &bw, 16);
                const int cb = (64 * chh + 32 * kbl + 4 * g) * 2;
#define GLA_OI(oacc, itv) do { const u32x2 x0 = *(const LAS u32x2*)(QE + (16 * (itv) + fr) * STQ + cb), x1 = *(const LAS u32x2*)(QE + (16 * (itv) + fr) * STQ + cb + 32); \
                    const u32x4 aw = (u32x4){x0.x, x0.y, x1.x, x1.y}; bf16x8 af; __builtin_memcpy(&af, &aw, 16); oacc = __builtin_amdgcn_mfma_f32_16x16x32_bf16(af, bfr, oacc, 0, 0, 0); } while (0)
                GLA_OI(o0, 0); GLA_OI(o1, 1); GLA_OI(o2, 2); GLA_OI(o3, 3);
            }
#define GLA_SU(Sx, ct) do { const f32x4 ev = *(const LAS f32x4*)(EG + 64 * chh + 16 * (ct) + 4 * g); Sx = Sx * ev; \
                _Pragma("unroll") for (int kb = 0; kb < 2; ++kb) { const bf16x8 a = *(const LAS bf16x8*)(KDT + (64 * chh + 16 * (ct) + fr) * STT + (32 * kb + 8 * g) * 2), bb = *(const LAS bf16x8*)(VT + (16 * vt + fr) * STT + (32 * kb + 8 * g) * 2); \
                    Sx = __builtin_amdgcn_mfma_f32_16x16x32_bf16(a, bb, Sx, 0, 0, 0); } } while (0)
            GLA_SU(S0, 0); GLA_SU(S1, 1); GLA_SU(S2, 2); GLA_SU(S3, 3);
            __syncthreads();
#define GLA_OA(oacc, itv) do { const bf16x8 a = *(const LAS bf16x8*)(ATT + (16 * (itv) + fr) * STT + (32 * chh + 8 * g) * 2), bb = *(const LAS bf16x8*)(VT + (16 * vt + fr) * STT + (32 * chh + 8 * g) * 2); \
                oacc = __builtin_amdgcn_mfma_f32_16x16x32_bf16(a, bb, oacc, 0, 0, 0); } while (0)
            GLA_OA(o0, 0); GLA_OA(o1, 1); GLA_OA(o2, 2); GLA_OA(o3, 3);
            f32x4 m0, m1, x0, x1;
            if (chh) { m0 = o2; m1 = o3; x0 = o0; x1 = o1; } else { m0 = o0; m1 = o1; x0 = o2; x1 = o3; }
            *(LAS f32x4*)(OP + ((vt * 2 + chh) * 2 + 0) * 1024 + lane * 16) = x0; *(LAS f32x4*)(OP + ((vt * 2 + chh) * 2 + 1) * 1024 + lane * 16) = x1;
            __syncthreads();
            m0 += *(const LAS f32x4*)(OP + ((vt * 2 + (1 - chh)) * 2 + 0) * 1024 + lane * 16); m1 += *(const LAS f32x4*)(OP + ((vt * 2 + (1 - chh)) * 2 + 1) * 1024 + lane * 16);
            bf16_t* ob = c.Z + (size_t)r0 * ZC + ZV + h * 256 + s * 64 + 16 * vt + fr;
#pragma unroll
            for (int r = 0; r < 4; ++r) { const int i0 = 16 * (2 * chh) + 4 * g + r, i1 = i0 + 16;
                if (i0 < nvalid) ob[(size_t)i0 * ZC] = f2bf(m0[r]);
                if (i1 < nvalid) ob[(size_t)i1 * ZC] = f2bf(m1[r]); }
        }
        if (seg == 0) { f32x4* sp = (f32x4*)(stsave + ((size_t)chain * 512 + c.tid) * 16); sp[0] = S0; sp[1] = S1; sp[2] = S2; sp[3] = S3; }
        __syncthreads();
#undef GLA_LOAD
#undef GLA_OI
#undef GLA_SU
#undef GLA_OA
    }
}
#define ONE_LAUNCH 1
#define P1_IMPL p1_opt
#define P2_IMPL gla_opt
#define P3_IMPL p3_opt
#define P4_IMPL p4_opt
#define P5_IMPL p5_opt
#define GU_IMPL gu_opt
#define DN_IMPL dn_opt
constexpr int N_PHASES = 28;
struct Params { const float* in[19]; float* out; unsigned char* ws; int ph_lo, ph_hi; };
#ifndef ONE_LAUNCH
#define ONE_LAUNCH 1
#endif
__global__ void __launch_bounds__(512, 2) k_fwd(Params p) {
    extern __shared__ __attribute__((aligned(16))) unsigned char lds_raw[];
    Ctx c;
    c.out = p.out; c.ws = p.ws; c.lds = (LAS unsigned char*)lds_raw;
    c.tid = threadIdx.x; c.lane = c.tid & 63; c.wave = __builtin_amdgcn_readfirstlane(c.tid >> 6); c.G = gridDim.x; c.wg = blockIdx.x;
    c.ctl = (unsigned*)(p.ws + WS_CTL); c.H = (float*)(p.ws + WS_H); c.HB = (bf16_t*)(p.ws + WS_HB); c.SS = (float*)(p.ws + WS_SS); c.Z = (bf16_t*)(p.ws + WS_Z);
    volatile LAS unsigned* misc = (volatile LAS unsigned*)(c.lds + MISC_OFF);
    if (c.tid < 16) misc[c.tid] = 0u;
    if (c.tid == 0) {
#pragma unroll
        for (int k = 0; k < 19; ++k) { const unsigned long long a = (unsigned long long)p.in[k]; misc[16 + 2 * k] = (unsigned)a; misc[16 + 2 * k + 1] = (unsigned)(a >> 32); } }
    __syncthreads();
    const int lo = p.ph_lo, hi = p.ph_hi;
    if (hi - lo > 1) (void)xcd_barrier_post(c.ctl + CW_BAR, misc);
#define FRESH() do { w = layer_w(c, l); int t_ = threadIdx.x; asm volatile("" : "+v"(t_)); c.tid = t_; c.lane = t_ & 63; c.wave = __builtin_amdgcn_readfirstlane(t_ >> 6); int g_ = blockIdx.x; asm volatile("" : "+s"(g_)); c.wg = g_; } while (0)
#define IN(k) (lo <= (k) && (k) < hi)
#define SEAM(k) do { if (IN(k) && IN((k) + 1)) { XcdBarrier b2; b2.bar = (unsigned*)(c.ws + WS_CTL) + CW_BAR; b2.x = xb_xcc_id(); b2.st = (volatile LAS unsigned*)(c.lds + MISC_OFF); xcd_barrier(b2); } } while (0)
    LayerW w; int l = 0;
    if (IN(0)) { FRESH(); phase_prep(c); }
    SEAM(0);
    for (l = 0; l < 2; ++l) {
        const int base = 1 + 13 * l;
        for (int s = 0; s < 2; ++s) {
            const int sb = base + 5 * s, segbase = s ? SEG0_ROWS : 0, segrows = s ? SEG1_ROWS : SEG0_ROWS;
            if (IN(sb + 0)) { FRESH(); P1_IMPL(c, w, segbase, segrows); }
            SEAM(sb + 0);
            if (IN(sb + 1)) { FRESH(); P2_IMPL(c, s); FRESH(); pool_phase(c, s); }
            SEAM(sb + 1);
            if (IN(sb + 2)) { FRESH(); P3_IMPL(c, w, segbase, segrows); FRESH(); ygla_phase(c, w, segrows); }
            SEAM(sb + 2);
            if (IN(sb + 3)) { FRESH(); P4_IMPL(c, w, segrows); }
            SEAM(sb + 3);
            if (IN(sb + 4)) { FRESH(); P5_IMPL(c, w, segbase, segrows); }
            SEAM(sb + 4);
        }
        if (IN(base + 10)) { FRESH(); route_phase(c, w, l); }
        SEAM(base + 10);
        if (IN(base + 11)) { FRESH(); GU_IMPL(c, w, l); }
        SEAM(base + 11);
        if (IN(base + 12)) { FRESH(); DN_IMPL(c, w, l); }
        SEAM(base + 12);
    }
    l = 1;
    if (IN(27)) { FRESH(); final_phase(c); }
#undef IN
#undef SEAM
}

extern "C" void kernel_launch(void* const* d_in, const int* in_sizes, int n_in, void* d_out, int out_size, void* d_ws, size_t ws_size, hipStream_t stream) {
    static int grid = 0;
    if (grid == 0) {
        if (n_in != 19 || out_size != NB * SEQ * DM || ws_size < WS_END) { fprintf(stderr, "kernel_launch: unexpected shapes (n_in %d out %d ws %zu need %zu)\n", n_in, out_size, ws_size, (size_t)WS_END); grid = -1; return; }
        int dev = 0, cus = 0, per_cu = 0;
        if (hipGetDevice(&dev) != hipSuccess || hipDeviceGetAttribute(&cus, hipDeviceAttributeMultiprocessorCount, dev) != hipSuccess) { grid = -1; return; }
        if (hipFuncSetAttribute((const void*)k_fwd, hipFuncAttributeMaxDynamicSharedMemorySize, LDS_BYTES) != hipSuccess) { fprintf(stderr, "kernel_launch: hipFuncSetAttribute failed\n"); grid = -1; return; }
        if (hipOccupancyMaxActiveBlocksPerMultiprocessor(&per_cu, (const void*)k_fwd, 512, LDS_BYTES) != hipSuccess || per_cu < 1) fprintf(stderr, "kernel_launch: occupancy query says %d\n", per_cu);
        (void)hipGetLastError();
        grid = cus;
    }
    if (grid < 0) return;
    if (hipMemsetAsync((char*)d_ws + WS_CTL, 0, CTL_BYTES, stream) != hipSuccess) return;
    Params p{};
    for (int i = 0; i < 19; ++i) p.in[i] = (const float*)d_in[i];
    p.out = (float*)d_out; p.ws = (unsigned char*)d_ws;
#if ONE_LAUNCH
    p.ph_lo = 0; p.ph_hi = N_PHASES;
    hipLaunchKernelGGL(k_fwd, dim3(grid), dim3(512), LDS_BYTES, stream, p);
#else
    for (int k = 0; k < N_PHASES; ++k) { p.ph_lo = k; p.ph_hi = k + 1; hipLaunchKernelGGL(k_fwd, dim3(grid), dim3(512), LDS_BYTES, stream, p); }
#endif
}
```

```cpp
#define ONE_LAUNCH 1
#define P1_IMPL p1_opt
#define P2_IMPL gla_opt
#define P4_IMPL p4_opt
#define P5_IMPL p5_opt
#define GU_IMPL gu_opt
#define DN_IMPL dn_opt
#include <hip/hip_runtime.h>
#include <stdint.h>
#include <stdio.h>

typedef unsigned short bf16_t;
typedef short bf16x8 __attribute__((ext_vector_type(8)));
typedef float f32x4 __attribute__((ext_vector_type(4)));
typedef float f32x2 __attribute__((ext_vector_type(2)));
typedef unsigned u32x4 __attribute__((ext_vector_type(4)));
typedef unsigned u32x2 __attribute__((ext_vector_type(2)));
#define LAS __attribute__((address_space(3)))

constexpr int DM = 1024, NB = 16, SEQ = 2048, NMETA = 16, LSEQ = SEQ + NMETA, T = NB * LSEQ;
constexpr int SEG0_LEN = 1040, SEG1_LEN = 1024, SEG0_ROWS = NB * SEG0_LEN, SEG1_ROWS = NB * SEG1_LEN;
constexpr int ZC = 6656;
constexpr int ZQ = 0, ZK = 512, ZV = 1024, ZOG = 2048, ZG = 3072, ZU = 3584, ZG0 = 4608, ZG1 = 5632;
constexpr int IN_COLS = 6160;
constexpr int NCLS = 24, MAXCT = 160;
constexpr float EPS = 1e-6f;

constexpr size_t WS_CTL = 0;
constexpr size_t CTL_BYTES = 65536;
constexpr size_t WS_H = WS_CTL + CTL_BYTES;
constexpr size_t WS_HB = WS_H + (size_t)T * DM * 4;
constexpr size_t WS_SS = WS_HB + (size_t)T * DM * 2;
constexpr size_t WS_Z = WS_SS + (size_t)T * 16 * 4;
constexpr size_t Z_BYTES = (size_t)SEG0_ROWS * ZC * 2;
constexpr size_t WS_W0 = WS_Z + Z_BYTES;
constexpr size_t W_IN = 0, W_GRP = W_IN + (size_t)ZC * DM * 2, W_BRG = W_GRP + 4 * 256 * 256 * 2, W_BRP = W_BRG + (size_t)DM * DM * 2, W_OUT = W_BRP + (size_t)DM * DM * 2,
                 W_GU = W_OUT + (size_t)DM * DM * 2, W_DN = W_GU + (size_t)16 * 1024 * 1024 * 2, W_BYTES = W_DN + (size_t)16 * 1024 * 512 * 2;
constexpr size_t WS_STATE = WS_W0 + W_BYTES;
constexpr size_t WS_HALO = WS_STATE + (size_t)256 * 8192 * 4;
constexpr size_t WS_END = WS_HALO + (size_t)16 * 15 * 1024 * 2;
constexpr size_t MZ_HID = 0;
constexpr size_t MZ_LIST = MZ_HID + (size_t)MAXCT * 256 * 1024 * 2;
constexpr size_t MZ_WTS = MZ_LIST + (size_t)NCLS * T * 4;
constexpr size_t MZ_END = MZ_WTS + (size_t)NCLS * T * 16;
static_assert(MZ_END <= Z_BYTES, "MoE buffers must fit the z region");
static_assert(WS_END <= (size_t)536870912, "workspace");
static_assert(W_BYTES <= (size_t)NB * SEQ * DM * 4, "layer-1 weights must fit d_out");
constexpr int CW_BAR = 0;
constexpr int CW_CNT = 4096;
constexpr int CW_TICKET = 8192;

constexpr int LDS_BYTES = 160 * 1024;
constexpr int MISC_OFF = LDS_BYTES - 256;

__device__ __forceinline__ float bf2f(bf16_t v) { return __uint_as_float(((unsigned)v) << 16); }
__device__ __forceinline__ bf16_t f2bf(float f) { unsigned u = __float_as_uint(f); u += 0x7FFFu + ((u >> 16) & 1u); return (bf16_t)(u >> 16); }
__device__ __forceinline__ unsigned pk2(float lo, float hi) { unsigned r; asm volatile("v_cvt_pk_bf16_f32 %0, %1, %2" : "=v"(r) : "v"(lo), "v"(hi)); return r; }
__device__ __forceinline__ float bflo(unsigned u) { return __uint_as_float(u << 16); }
__device__ __forceinline__ float bfhi(unsigned u) { return __uint_as_float(u & 0xffff0000u); }
__device__ __forceinline__ float sigmoidf_(float x) { return 1.0f / (1.0f + __expf(-x)); }
__device__ __forceinline__ float siluf_(float x) { return x / (1.0f + __expf(-x)); }
__device__ __forceinline__ float logsigmoidf_(float x) { return fminf(x, 0.f) - __logf(1.0f + __expf(-fabsf(x))); }
template <int M> __device__ __forceinline__ float shx(float v) {
    static_assert(M < 32, "use xsum32");
    return __int_as_float(__builtin_amdgcn_ds_swizzle(__float_as_int(v), 0x1f | (M << 10)));
}
__device__ __forceinline__ float xsum32(float v) { const auto r = __builtin_amdgcn_permlane32_swap(__float_as_uint(v), __float_as_uint(v), false, false); return __uint_as_float(r[0]) + __uint_as_float(r[1]); }
__device__ __forceinline__ float wave_sum(float v) { v += shx<1>(v); v += shx<2>(v); v += shx<4>(v); v += shx<8>(v); v += shx<16>(v); return xsum32(v); }
__device__ __forceinline__ int row_of(int b, int p) { return p < SEG0_LEN ? b * SEG0_LEN + p : SEG0_ROWS + b * SEG1_LEN + (p - SEG0_LEN); }
__device__ __forceinline__ void bp_of(int row, int& b, int& p) { if (row < SEG0_ROWS) { b = row / SEG0_LEN; p = row - b * SEG0_LEN; } else { const int r = row - SEG0_ROWS; b = r >> 10; p = SEG0_LEN + (r & 1023); } }
#define XB_TMO      128
#define XB_XCNT(j)  (256  + 64 * (j))
#define XB_XSUB(j)  (1280 + 64 * (j))
#define XB_XGEN(j)  (2304 + 64 * (j))
#define XB_TOP      3328
#define XB_TOPGEN   3392
#define XCD_BAR_WORDS 3456
#define XB_SPIN_CAP (1u << 18)
#define LAS __attribute__((address_space(3)))

__device__ __forceinline__ unsigned xb_ld(unsigned* p)              { return __hip_atomic_load(p, __ATOMIC_RELAXED, __HIP_MEMORY_SCOPE_AGENT); }
__device__ __forceinline__ unsigned xb_add(unsigned* p, unsigned v) { return __hip_atomic_fetch_add(p, v, __ATOMIC_RELAXED, __HIP_MEMORY_SCOPE_AGENT); }
__device__ __forceinline__ unsigned xb_xcc_id() { return (unsigned)__builtin_amdgcn_s_getreg((3 << 11) | 20) & 0xFu; }
#define XB_SPIN(cond, bar) do { unsigned _sp = 0; while (cond) { __builtin_amdgcn_s_sleep(1); \
    if ((++_sp & 255u) == 0u) { if (xb_ld(&(bar)[XB_TMO])) break; if (_sp > XB_SPIN_CAP) { atomicAdd(&(bar)[XB_TMO], 1u); break; } } } } while (0)

struct XcdBarrier {
    unsigned* bar; unsigned x;
    volatile LAS unsigned* st;
};

__device__ __forceinline__ XcdBarrier xcd_barrier_post(unsigned* bar, volatile LAS unsigned* st) {
    XcdBarrier b; b.bar = bar; b.x = xb_xcc_id(); b.st = st;
    if (threadIdx.x == 0) (void)xb_add(&bar[XB_XCNT(b.x)], 1u);
    return b;
}
__device__ __forceinline__ void xcd_barrier_complete(unsigned* bar, unsigned x, unsigned& nloc, unsigned& nx) {
    const unsigned G = gridDim.x * gridDim.y * gridDim.z;
    unsigned sum, cnt, mine, sp = 0u;
    for (;;) {
        sum = 0u; cnt = 0u; mine = 0u;
#pragma unroll
        for (unsigned j = 0; j < 16; ++j) { const unsigned c = xb_ld(&bar[XB_XCNT(j)]); sum += c; cnt += (c > 0u) ? 1u : 0u; mine = (j == x) ? c : mine; }
        if (sum == G) break;
        __builtin_amdgcn_s_sleep(1);
        if ((++sp & 255u) == 0u) { if (xb_ld(&bar[XB_TMO])) break; if (sp > XB_SPIN_CAP) { atomicAdd(&bar[XB_TMO], 1u); break; } }
    }
    nloc = mine > 0u ? mine : 1u; nx = cnt > 0u ? cnt : 1u;
}

__device__ __forceinline__ void xcd_barrier(const XcdBarrier& b) {
    asm volatile("s_waitcnt vmcnt(0)" ::: "memory");
    __syncthreads();
    if (threadIdx.x == 0) {
        unsigned* bar = b.bar;
        __builtin_amdgcn_s_waitcnt(0);
        unsigned nloc = b.st[0], nx = b.st[1];
        if (nloc == 0u) { xcd_barrier_complete(bar, b.x, nloc, nx); b.st[0] = nloc; b.st[1] = nx; }
        const unsigned old = xb_add(&bar[XB_XSUB(b.x)], 1u);
        const unsigned gen = old / nloc;
        if (old + 1u == (gen + 1u) * nloc) {
            __builtin_amdgcn_fence(__ATOMIC_RELEASE, "agent");
            asm volatile("s_waitcnt vmcnt(0)" ::: "memory");
            const unsigned og = xb_add(&bar[XB_TOP], 1u);
            const unsigned tg = og / nx;
            if (og + 1u == (tg + 1u) * nx) xb_add(&bar[XB_TOPGEN], 1u);
            else XB_SPIN(xb_ld(&bar[XB_TOPGEN]) == tg, bar);
            __builtin_amdgcn_fence(__ATOMIC_ACQUIRE, "agent");
            xb_add(&bar[XB_XGEN(b.x)], 1u);
            asm volatile("s_waitcnt vmcnt(0)" ::: "memory");
        } else {
            XB_SPIN(xb_ld(&bar[XB_XGEN(b.x)]) == gen, bar);
            __builtin_amdgcn_fence(__ATOMIC_ACQUIRE, "agent");
            asm volatile("s_waitcnt vmcnt(0)" ::: "memory");
        }
    }
    __syncthreads();
}
#define DPP_ADD(v, ctrl) ((v) + __int_as_float(__builtin_amdgcn_update_dpp(0, __float_as_int(v), (ctrl), 0xf, 0xf, true)))
__device__ __forceinline__ float row16_sum(float v) { v = DPP_ADD(v, 0xB1); v = DPP_ADD(v, 0x4E); v = DPP_ADD(v, 0x141); v = DPP_ADD(v, 0x140); return v; }
struct Ctx {
    float* out; unsigned char* ws;
    LAS unsigned char* lds; int tid, lane, wave, G, wg;
    unsigned* ctl; float* H; bf16_t* HB; float* SS; bf16_t* Z;
};
__device__ __forceinline__ const float* inp(const Ctx& c, int k) {
    const LAS unsigned* t = (const LAS unsigned*)(c.lds + MISC_OFF + 64) + 2 * k;
    const unsigned lo = __builtin_amdgcn_readfirstlane(t[0]), hi = __builtin_amdgcn_readfirstlane(t[1]);
    return (const float*)(((unsigned long long)hi << 32) | lo);
}
struct LayerW {
    const bf16_t *Bin, *Bgrp, *Bbrg, *Bbrp, *Bout, *Bgu, *Bdn;
    const float *b_gate, *gla_nw, *pool_scale, *norm2_w, *w_rg, *w_re;
};
__device__ __forceinline__ LayerW layer_w(const Ctx& c, int l) {
    LayerW w; const unsigned char* base = (l == 0) ? (c.ws + WS_W0) : (const unsigned char*)c.out;
    w.Bin = (const bf16_t*)(base + W_IN); w.Bgrp = (const bf16_t*)(base + W_GRP); w.Bbrg = (const bf16_t*)(base + W_BRG); w.Bbrp = (const bf16_t*)(base + W_BRP);
    w.Bout = (const bf16_t*)(base + W_OUT); w.Bgu = (const bf16_t*)(base + W_GU); w.Bdn = (const bf16_t*)(base + W_DN);
    w.b_gate = inp(c, 5) + l * 512; w.gla_nw = inp(c, 6) + l * 256; w.pool_scale = inp(c, 8) + l * 1024; w.norm2_w = inp(c, 12) + l * 1024;
    w.w_rg = inp(c, 13) + (size_t)l * 1024 * 4; w.w_re = inp(c, 14) + (size_t)l * 1024 * 16;
    return w;
}

__device__ __forceinline__ float ss_row(const float* SS, int row) { const f32x4* p = (const f32x4*)(SS + (size_t)row * 16); const f32x4 a = p[0], b = p[1], c2 = p[2], d = p[3];
    return (((a[0] + a[1]) + (a[2] + a[3])) + ((b[0] + b[1]) + (b[2] + b[3]))) + (((c2[0] + c2[1]) + (c2[2] + c2[3])) + ((d[0] + d[1]) + (d[2] + d[3]))); }
template <int NS>
__device__ __forceinline__ void sg_acc_n(f32x4 (&acc)[4], const bf16_t* arow, const bf16_t* B, int ldb, int brow0, int lane) {
    const bf16_t* ap = arow + 8 * (lane >> 4);
    const bf16_t* bp = B + (size_t)(brow0 + (lane & 15)) * ldb + 8 * (lane >> 4);
    bf16x8 a[NS], b[NS][4];
#pragma unroll
    for (int s = 0; s < NS; ++s) { a[s] = *(const bf16x8*)(ap + 32 * s);
#pragma unroll
        for (int j = 0; j < 4; ++j) b[s][j] = *(const bf16x8*)(bp + (size_t)(16 * j) * ldb + 32 * s); }
#pragma unroll
    for (int s = 0; s < NS; ++s)
#pragma unroll
        for (int j = 0; j < 4; ++j) acc[j] = __builtin_amdgcn_mfma_f32_16x16x32_bf16(a[s], b[s][j], acc[j], 0, 0, 0);
}
#define ZERO_ACC(acc) do { _Pragma("unroll") for (int _j = 0; _j < 4; ++_j) acc[_j] = (f32x4){0.f, 0.f, 0.f, 0.f}; } while (0)
struct CvtItem { const float* src; int ldS, k0, n0; bf16_t* dst; int ldD, drow0; const float* rs; float cs; };
constexpr int CVT_A = 80 * 4, CVT_B = 0, CVT_C = 3 * 16 * 4, CVT_D = 16 * 16 * 4, CVT_E = 16 * 16 * 2, CVT_PER_LAYER = CVT_A + CVT_B + CVT_C + CVT_D + CVT_E;
__device__ __forceinline__ void cvt_decode(const Ctx& c, int l, int idx, CvtItem& it) {
    const uintptr_t i9 = (uintptr_t)inp(c, 9), i10 = (uintptr_t)inp(c, 10), i11 = (uintptr_t)inp(c, 11), i15 = (uintptr_t)inp(c, 15), i16 = (uintptr_t)inp(c, 16);
    unsigned char* base = (l == 0) ? (c.ws + WS_W0) : (unsigned char*)c.out;
    it.rs = nullptr; it.cs = 1.0f;
    if (idx < CVT_A) { const int nb = idx >> 2, kb = idx & 3;
        it.src = inp(c, 3) + (size_t)l * DM * IN_COLS; it.ldS = IN_COLS; it.k0 = kb * 256; it.dst = (bf16_t*)(base + W_IN); it.ldD = DM; it.rs = inp(c, 2) + l * DM;
        if (nb < 48) { it.n0 = nb * 64; it.drow0 = nb * 64; if (nb < 8) it.cs = 0.08838834764831845f; }
        else { it.n0 = 4112 + (nb - 48) * 64; it.drow0 = ZG0 + (nb - 48) * 64; }
        return; }
    idx -= CVT_A;
    if (idx < CVT_C) { const int m = idx >> 6, r = idx & 63, nb = r >> 2, kb = r & 3;
        it.src = (const float*)(m == 0 ? i9 : (m == 1 ? i10 : i11)) + (size_t)l * DM * DM; it.ldS = DM; it.k0 = kb * 256; it.n0 = nb * 64;
        it.dst = (bf16_t*)(base + (m == 0 ? W_BRG : (m == 1 ? W_BRP : W_OUT))); it.ldD = DM; it.drow0 = nb * 64; return; }
    idx -= CVT_C;
    if (idx < CVT_D) { const int e = idx >> 6, r = idx & 63, rb = r >> 2, kb = r & 3, j = rb >> 2, sub = rb & 3;
        const float* sp = (const float*)((sub < 2) ? i15 : i16);
        it.src = sp + ((size_t)l * 16 + e) * 1024 * 512; it.ldS = 512; it.k0 = kb * 256; it.n0 = 128 * j + 64 * (sub & 1);
        it.dst = (bf16_t*)(base + W_GU) + (size_t)e * 1024 * 1024; it.ldD = 1024; it.drow0 = rb * 64; it.rs = inp(c, 12) + l * DM; return; }
    idx -= CVT_D;
    { const int e = idx >> 5, r = idx & 31, nb = r >> 1, kb = r & 1;
        it.src = inp(c, 17) + ((size_t)l * 16 + e) * 512 * 1024; it.ldS = 1024; it.k0 = kb * 256; it.n0 = nb * 64;
        it.dst = (bf16_t*)(base + W_DN) + (size_t)e * 1024 * 512; it.ldD = 512; it.drow0 = nb * 64; }
}
__device__ __forceinline__ void phase_prep(const Ctx& c) {
    for (int row = c.wg * 8 + c.wave; row < T; row += c.G * 8) {
        int b, p; bp_of(row, b, p);
        const float* src = (p < NMETA) ? (inp(c, 1) + (size_t)p * DM) : (inp(c, 0) + ((size_t)b * SEQ + (p - NMETA)) * DM);
        float ss = 0.f;
#pragma unroll
        for (int i = 0; i < 4; ++i) { const int col = c.lane * 4 + 256 * i; const f32x4 v = *(const f32x4*)(src + col);
            ss += v[0] * v[0] + v[1] * v[1] + v[2] * v[2] + v[3] * v[3];
            *(f32x4*)(c.H + (size_t)row * DM + col) = v;
            u32x2 w; w.x = pk2(v[0], v[1]); w.y = pk2(v[2], v[3]); *(u32x2*)(c.HB + (size_t)row * DM + col) = w; }
        ss = wave_sum(ss);
        if (c.lane < 16) c.SS[(size_t)row * 16 + c.lane] = (c.lane == 0) ? ss : 0.f;
    }
    LAS float* tile = (LAS float*)c.lds;
    for (int idx = c.wg; idx < 2 * CVT_PER_LAYER; idx += c.G) {
        const int l = idx / CVT_PER_LAYER; CvtItem it; cvt_decode(c, l, idx - l * CVT_PER_LAYER, it);
        __syncthreads();
        float v[32];
#pragma unroll
        for (int i = 0; i < 32; ++i) { const int e = c.tid + 512 * i, kk = e >> 6, nn = e & 63; v[i] = it.src[(size_t)(it.k0 + kk) * it.ldS + it.n0 + nn]; }
#pragma unroll
        for (int i = 0; i < 32; ++i) { const int e = c.tid + 512 * i, kk = e >> 6, nn = e & 63; float x = v[i] * it.cs; if (it.rs) x *= it.rs[it.k0 + kk]; tile[kk * 65 + nn] = x; }
        __syncthreads();
#pragma unroll
        for (int i = 0; i < 16; ++i) { const int e = c.tid + 512 * i, nn = e >> 7, kp = e & 127;
            *(unsigned*)(it.dst + (size_t)(it.drow0 + nn) * it.ldD + it.k0 + 2 * kp) = pk2(tile[(2 * kp) * 65 + nn], tile[(2 * kp + 1) * 65 + nn]); }
    }
    __syncthreads();
    for (int idx = c.wg * 512 + c.tid; idx < 2 * 64 * 1024; idx += c.G * 512) {
        const int l = idx >> 16, jb = (idx >> 10) & 63, k = idx & 1023;
        const f32x4* wi4 = (const f32x4*)(inp(c, 3) + (size_t)l * DM * IN_COLS + (size_t)k * IN_COLS + 3072); const float* wu = inp(c, 4) + (size_t)l * 16 * 512 + 8 * jb;
        float wi[16];
#pragma unroll
        for (int q = 0; q < 4; ++q) { const f32x4 t4 = wi4[q]; wi[4 * q] = t4[0]; wi[4 * q + 1] = t4[1]; wi[4 * q + 2] = t4[2]; wi[4 * q + 3] = t4[3]; }
        float a[8];
#pragma unroll
        for (int j = 0; j < 8; ++j) a[j] = 0.f;
#pragma unroll
        for (int r = 0; r < 16; ++r) { const f32x4 u0 = *(const f32x4*)(wu + r * 512), u1 = *(const f32x4*)(wu + r * 512 + 4);
#pragma unroll
            for (int j = 0; j < 4; ++j) { a[j] += wi[r] * u0[j]; a[4 + j] += wi[r] * u1[j]; } }
        unsigned char* base = (l == 0) ? (c.ws + WS_W0) : (unsigned char*)c.out; const float nw = inp(c, 2)[l * DM + k];
#pragma unroll
        for (int j = 0; j < 8; ++j) ((bf16_t*)(base + W_IN))[(size_t)(ZG + 8 * jb + j) * DM + k] = f2bf(a[j] * nw);
    }
    for (int t = c.wg * 8 + c.wave; t < 2 * 64 * 16; t += c.G * 8) {
        const int l = t >> 10, k0 = ((t >> 4) & 63) * 16, n0 = (t & 15) * 64, g = n0 >> 8;
        const float* A = inp(c, 3) + (size_t)l * DM * IN_COLS + (size_t)(k0 + (c.lane & 15)) * IN_COLS + 3088 + 256 * g + (c.lane >> 4);
        const float* Bm = inp(c, 7) + (size_t)l * 4 * 65536 + (size_t)g * 65536 + (size_t)(c.lane >> 4) * 256 + (n0 & 255) + (c.lane & 15);
        f32x4 acc[4]; ZERO_ACC(acc);
#pragma unroll 4
        for (int c0 = 0; c0 < 256; c0 += 4) { const float a = A[c0];
#pragma unroll
            for (int j = 0; j < 4; ++j) acc[j] = __builtin_amdgcn_mfma_f32_16x16x4f32(a, Bm[(size_t)c0 * 256 + 16 * j], acc[j], 0, 0, 0); }
        unsigned char* base = (l == 0) ? (c.ws + WS_W0) : (unsigned char*)c.out; const float* nw = inp(c, 2) + l * DM + k0 + 4 * (c.lane >> 4); const float* sc = inp(c, 8) + l * 1024;
#pragma unroll
        for (int j = 0; j < 4; ++j) { const int n = n0 + 16 * j + (c.lane & 15); const float s = sc[n]; u32x2 pk; pk.x = pk2(acc[j][0] * nw[0] * s, acc[j][1] * nw[1] * s); pk.y = pk2(acc[j][2] * nw[2] * s, acc[j][3] * nw[3] * s);
            *(u32x2*)((bf16_t*)(base + W_IN) + (size_t)(ZU + n) * DM + k0 + 4 * (c.lane >> 4)) = pk; }
    }
}

__device__ __forceinline__ void sg_acc(f32x4 (&acc)[4], const bf16_t* arow, const bf16_t* B, int ldb, int brow0, int K, int lane) {
    const bf16_t* ap = arow + 8 * (lane >> 4);
    const bf16_t* bp = B + (size_t)(brow0 + (lane & 15)) * ldb + 8 * (lane >> 4);
    for (int k0 = 0; k0 < K; k0 += 32) {
        const bf16x8 a = *(const bf16x8*)(ap + k0);
#pragma unroll
        for (int j = 0; j < 4; ++j) { const bf16x8 b = *(const bf16x8*)(bp + (size_t)(16 * j) * ldb + k0); acc[j] = __builtin_amdgcn_mfma_f32_16x16x32_bf16(a, b, acc[j], 0, 0, 0); }
    }
}

__device__ __forceinline__ void pool_phase(const Ctx& c, int seg) {
    const int segbase = seg ? SEG0_ROWS : 0, segrows = seg ? SEG1_ROWS : SEG0_ROWS, seglen = seg ? SEG1_LEN : SEG0_LEN;
    bf16_t* halo = (bf16_t*)(c.ws + WS_HALO);
    const int RB = seg ? 16 : 20;
    const int nitem = (segrows / RB) * 128;
    for (int it = c.wg * 512 + c.tid; it < nitem; it += c.G * 512) {
        const int rb = it >> 7, cc = (it & 127) * 8, r0 = rb * RB, b = r0 / seglen, pl0 = r0 - b * seglen, p0 = seg ? SEG0_LEN + pl0 : pl0;
        const int w = 2 << (cc >> 8);
        float s[8];
#pragma unroll
        for (int j = 0; j < 8; ++j) s[j] = 0.f;
#define POOL_LD(dst, pl) do { const int pl_ = (pl); if (pl_ >= 0) dst = *(const u32x4*)(c.Z + (size_t)(b * seglen + pl_) * ZC + ZU + cc); else dst = *(const u32x4*)(halo + ((size_t)b * 15 + (15 + pl_)) * 1024 + cc); } while (0)
#define POOL_ACC(v, sgn) do { _Pragma("unroll") for (int j = 0; j < 4; ++j) { s[2 * j] += (sgn) * __uint_as_float((v)[j] << 16); s[2 * j + 1] += (sgn) * __uint_as_float((v)[j] & 0xffff0000u); } } while (0)
        { u32x4 hv[15];
#pragma unroll
          for (int i = 1; i < 16; ++i) { hv[i - 1] = (u32x4){0u, 0u, 0u, 0u}; if (i < w && p0 - i >= 0) POOL_LD(hv[i - 1], pl0 - i); }
#pragma unroll
          for (int i = 1; i < 16; ++i) POOL_ACC(hv[i - 1], 1.0f); }
        for (int rq = 0; rq < RB; rq += 4) {
            u32x4 cur[4], old[4];
#pragma unroll
            for (int q = 0; q < 4; ++q) { POOL_LD(cur[q], pl0 + rq + q); old[q] = (u32x4){0u, 0u, 0u, 0u}; if (p0 + rq + q - (w - 1) >= 0) POOL_LD(old[q], pl0 + rq + q - (w - 1)); }
#pragma unroll
            for (int q = 0; q < 4; ++q) { const int r = rq + q; POOL_ACC(cur[q], 1.0f);
                const int p = p0 + r, cnt = (p + 1 < w) ? p + 1 : w; const float inv = 1.0f / (float)cnt; u32x4 o;
#pragma unroll
                for (int j = 0; j < 4; ++j) o[j] = pk2(s[2 * j] * inv - __uint_as_float(cur[q][j] << 16), s[2 * j + 1] * inv - __uint_as_float(cur[q][j] & 0xffff0000u));
                *(u32x4*)(c.Z + (size_t)(r0 + r) * ZC + ZQ + cc) = o;
                if (seg == 0 && pl0 + r >= SEG0_LEN - 15) *(u32x4*)(halo + ((size_t)b * 15 + (pl0 + r - (SEG0_LEN - 15))) * 1024 + cc) = cur[q];
                POOL_ACC(old[q], -1.0f); }
        }
#undef POOL_LD
#undef POOL_ACC
    }
}
__device__ __forceinline__ void ygla_phase(const Ctx& c, const LayerW& w, int segrows) {
    const int col = c.lane * 16;
    float nwv[16];
    { const f32x4* np = (const f32x4*)(w.gla_nw + (col & 255));
#pragma unroll
      for (int q = 0; q < 4; ++q) { const f32x4 t4 = np[q]; nwv[4 * q] = t4[0]; nwv[4 * q + 1] = t4[1]; nwv[4 * q + 2] = t4[2]; nwv[4 * q + 3] = t4[3]; } }
    for (int r = (c.wg * 8 + c.wave) * 2; r < segrows; r += c.G * 16) {
        u32x4 ov[2][2], gv[2][2];
#pragma unroll
        for (int q = 0; q < 2; ++q) { const bf16_t* zr = c.Z + (size_t)(r + q) * ZC; ov[q][0] = *(const u32x4*)(zr + ZV + col); ov[q][1] = *(const u32x4*)(zr + ZV + col + 8); gv[q][0] = *(const u32x4*)(zr + ZOG + col); gv[q][1] = *(const u32x4*)(zr + ZOG + col + 8); }
#pragma unroll
        for (int q = 0; q < 2; ++q) {
            float o[16], sg[16];
#pragma unroll
            for (int j = 0; j < 4; ++j) { o[2 * j] = __uint_as_float(ov[q][0][j] << 16); o[2 * j + 1] = __uint_as_float(ov[q][0][j] & 0xffff0000u); o[8 + 2 * j] = __uint_as_float(ov[q][1][j] << 16); o[8 + 2 * j + 1] = __uint_as_float(ov[q][1][j] & 0xffff0000u);
                sg[2 * j] = __uint_as_float(gv[q][0][j] << 16); sg[2 * j + 1] = __uint_as_float(gv[q][0][j] & 0xffff0000u); sg[8 + 2 * j] = __uint_as_float(gv[q][1][j] << 16); sg[8 + 2 * j + 1] = __uint_as_float(gv[q][1][j] & 0xffff0000u); }
            float ss = 0.f;
#pragma unroll
            for (int j = 0; j < 16; ++j) ss += o[j] * o[j];
            ss = row16_sum(ss);
            const float rs = rsqrtf(ss * (1.0f / 256.0f) + EPS);
            u32x4 y0, y1;
#pragma unroll
            for (int j = 0; j < 4; ++j) { y0[j] = pk2(o[2 * j] * rs * nwv[2 * j] * sg[2 * j], o[2 * j + 1] * rs * nwv[2 * j + 1] * sg[2 * j + 1]);
                y1[j] = pk2(o[8 + 2 * j] * rs * nwv[8 + 2 * j] * sg[8 + 2 * j], o[8 + 2 * j + 1] * rs * nwv[8 + 2 * j + 1] * sg[8 + 2 * j + 1]); }
            bf16_t* zr = c.Z + (size_t)(r + q) * ZC; *(u32x4*)(zr + ZOG + col) = y0; *(u32x4*)(zr + ZOG + col + 8) = y1; }
    }
}
__device__ __forceinline__ void route_phase(const Ctx& c, const LayerW& w, int layer) {
    constexpr int WST = 2064;
    LAS unsigned char* WH = c.lds; LAS unsigned char* WM = c.lds + 20 * WST;
    LAS float* LG = (LAS float*)(c.lds + 40 * WST);
    LAS unsigned* lcnt = (LAS unsigned*)(c.lds + 93184);
    LAS int* rinfo = (LAS int*)(c.lds + 93184 + 256);
    { f32x4 rg[2], re[2][4]; float nw[2];
#pragma unroll
      for (int q = 0; q < 2; ++q) { const int k = c.tid + 512 * q; rg[q] = *(const f32x4*)(w.w_rg + k * 4); nw[q] = w.norm2_w[k];
#pragma unroll
          for (int u = 0; u < 4; ++u) re[q][u] = *(const f32x4*)(w.w_re + k * 16 + 4 * u); }
#pragma unroll
      for (int q = 0; q < 2; ++q) { const int k = c.tid + 512 * q;
#pragma unroll
          for (int j = 0; j < 20; ++j) { const float v = ((j < 4) ? rg[q][j & 3] : re[q][(j - 4) >> 2][(j - 4) & 3]) * nw[q]; const bf16_t hi = f2bf(v); const bf16_t mid = f2bf(v - bf2f(hi));
              *(LAS bf16_t*)(WH + j * WST + 2 * k) = hi; *(LAS bf16_t*)(WM + j * WST + 2 * k) = mid; } } }
    if (c.tid < 64) lcnt[c.tid] = 0u;
    __syncthreads();
    int* LIST = (int*)((unsigned char*)c.Z + MZ_LIST); float* WTS = (float*)((unsigned char*)c.Z + MZ_WTS);
    unsigned* cnt = c.ctl + CW_CNT + layer * 2048;
    const int fr = c.lane & 15, g = c.lane >> 4;
    const int bn0 = fr, bn1 = (16 + fr < 20) ? 16 + fr : 19;
    constexpr int ntmax = 4;
    int nloc = 0;
    for (int tile = c.wg * 8 + c.wave; tile < T / 16; tile += c.G * 8, ++nloc) {
        const float* hr = c.H + (size_t)(tile * 16 + fr) * DM + 8 * g;
        f32x4 a0 = (f32x4){0.f, 0.f, 0.f, 0.f}, a1 = a0; float ss = 0.f;
#pragma unroll 4
        for (int s = 0; s < 32; ++s) {
            const f32x4 x0 = *(const f32x4*)(hr + 32 * s), x1 = *(const f32x4*)(hr + 32 * s + 4);
            ss += (x0[0] * x0[0] + x0[1] * x0[1]) + (x0[2] * x0[2] + x0[3] * x0[3]) + (x1[0] * x1[0] + x1[1] * x1[1]) + (x1[2] * x1[2] + x1[3] * x1[3]);
            const u32x4 hw = (u32x4){pk2(x0[0], x0[1]), pk2(x0[2], x0[3]), pk2(x1[0], x1[1]), pk2(x1[2], x1[3])};
            const u32x4 mw = (u32x4){pk2(x0[0] - bflo(hw[0]), x0[1] - bfhi(hw[0])), pk2(x0[2] - bflo(hw[1]), x0[3] - bfhi(hw[1])), pk2(x1[0] - bflo(hw[2]), x1[1] - bfhi(hw[2])), pk2(x1[2] - bflo(hw[3]), x1[3] - bfhi(hw[3]))};
            bf16x8 ah, am; __builtin_memcpy(&ah, &hw, 16); __builtin_memcpy(&am, &mw, 16);
            const int ko = (32 * s + 8 * g) * 2;
            const bf16x8 bh0 = *(const LAS bf16x8*)(WH + bn0 * WST + ko), bm0 = *(const LAS bf16x8*)(WM + bn0 * WST + ko), bh1 = *(const LAS bf16x8*)(WH + bn1 * WST + ko), bm1 = *(const LAS bf16x8*)(WM + bn1 * WST + ko);
            a0 = __builtin_amdgcn_mfma_f32_16x16x32_bf16(am, bh0, a0, 0, 0, 0); a0 = __builtin_amdgcn_mfma_f32_16x16x32_bf16(ah, bm0, a0, 0, 0, 0); a0 = __builtin_amdgcn_mfma_f32_16x16x32_bf16(ah, bh0, a0, 0, 0, 0);
            a1 = __builtin_amdgcn_mfma_f32_16x16x32_bf16(am, bh1, a1, 0, 0, 0); a1 = __builtin_amdgcn_mfma_f32_16x16x32_bf16(ah, bm1, a1, 0, 0, 0); a1 = __builtin_amdgcn_mfma_f32_16x16x32_bf16(ah, bh1, a1, 0, 0, 0);
        }
        ss += shx<16>(ss); ss = xsum32(ss);
        const float rstd = rsqrtf(ss * (1.0f / DM) + EPS);
        LAS float* lgw = LG + c.wave * 320;
#pragma unroll
        for (int r = 0; r < 4; ++r) { lgw[(4 * g + r) * 20 + fr] = a0[r]; if (fr < 4) lgw[(4 * g + r) * 20 + 16 + fr] = a1[r]; }
        asm volatile("s_waitcnt lgkmcnt(0)" ::: "memory");
        if (g == 0) {
            float lg[20];
#pragma unroll
            for (int j = 0; j < 5; ++j) { const f32x4 v = *(const LAS f32x4*)(lgw + fr * 20 + 4 * j); lg[4 * j] = v[0] * rstd; lg[4 * j + 1] = v[1] * rstd; lg[4 * j + 2] = v[2] * rstd; lg[4 * j + 3] = v[3] * rstd; }
            int gi = 0; float gm = lg[0];
#pragma unroll
            for (int j = 1; j < 4; ++j) if (lg[j] > gm) { gm = lg[j]; gi = j; }
            float den = 0.f;
#pragma unroll
            for (int j = 0; j < 4; ++j) den += __expf(lg[j] - gm);
            const float pg = 1.0f / den;
            float le[4];
#pragma unroll
            for (int j = 0; j < 4; ++j) le[j] = (gi == 0) ? +lg[4 + j] : (gi == 1) ? +lg[8 + j] : (gi == 2) ? +lg[12 + j] : +lg[16 + j];
            int i1 = 0; float m1 = le[0];
#pragma unroll
            for (int j = 1; j < 4; ++j) if (le[j] > m1) { m1 = le[j]; i1 = j; }
            int i2 = -1; float m2 = -3.0e38f;
#pragma unroll
            for (int j = 0; j < 4; ++j) if (j != i1 && le[j] > m2) { m2 = le[j]; i2 = j; }
            const float w1 = pg / (1.0f + __expf(m2 - m1)), w2 = pg - w1;
            const int a = i1 < i2 ? +i1 : +i2, bq = i1 < i2 ? +i2 : +i1; const float wa = i1 < i2 ? +w1 : +w2, wb = i1 < i2 ? +w2 : +w1;
            const int pidx = (a == 0) ? (bq - 1) : (a == 1) ? (bq + 1) : 5;
            const int cls = gi * 6 + pidx;
            const unsigned lslot = __hip_atomic_fetch_add(lcnt + cls, 1u, __ATOMIC_RELAXED, __HIP_MEMORY_SCOPE_WORKGROUP);
            LAS int* ri = rinfo + ((c.wave * ntmax + nloc) * 16 + fr) * 8;
            ri[0] = tile * 16 + fr; ri[1] = (cls << 16) | (int)lslot; ri[2] = __float_as_int(wa); ri[3] = __float_as_int(wb); ri[4] = __float_as_int(rstd);
        }
    }
    __syncthreads();
    if (c.tid < NCLS) { const unsigned n = lcnt[c.tid]; lcnt[32 + c.tid] = n ? atomicAdd(cnt + 64 * c.tid, n) : 0u; }
    __syncthreads();
    for (int e = c.tid; e < 8 * ntmax * 16; e += 512) { const int wv = e / (ntmax * 16), nl = (e / 16) % ntmax;
        int nmine = 0; for (int t0 = c.wg * 8 + wv; t0 < T / 16; t0 += c.G * 8) ++nmine;
        if (nl < nmine) { const LAS int* ri = rinfo + e * 8; const int row = ri[0], cls = ri[1] >> 16, ls = ri[1] & 0xffff;
            const size_t slot = (size_t)cls * T + lcnt[32 + cls] + ls; LIST[slot] = row; *(f32x4*)(WTS + slot * 4) = (f32x4){__int_as_float(ri[2]), __int_as_float(ri[3]), __int_as_float(ri[4]), 0.f}; } }
}
struct MoeTab { LAS int* cls; LAS int* til; LAS int* cntv; int ntiles; };
__device__ __forceinline__ MoeTab moe_table(const Ctx& c, int layer) {
    MoeTab mt; mt.cls = (LAS int*)(c.lds + MISC_OFF - 4096); mt.til = mt.cls + MAXCT; mt.cntv = mt.til + MAXCT;
    __syncthreads();
    if (c.tid == 0) { const unsigned* cnt = c.ctl + CW_CNT + layer * 2048; int n = 0;
#pragma unroll 1
        for (int k = 0; k < NCLS; ++k) { const int cv = (int)__hip_atomic_load(cnt + 64 * k, __ATOMIC_RELAXED, __HIP_MEMORY_SCOPE_AGENT); mt.cntv[k] = cv; const int nt = (cv + 255) >> 8;
#pragma unroll 1
            for (int t = 0; t < nt && n < MAXCT; ++t) { mt.cls[n] = k; mt.til[n] = t; ++n; } }
        mt.cntv[NCLS] = n; }
    __syncthreads();
    mt.ntiles = __builtin_amdgcn_readfirstlane(mt.cntv[NCLS]);
    return mt;
}
__device__ __forceinline__ void cls_experts(int cls, int& ea, int& eb) { const int g = cls / 6, pi = cls - g * 6; const int a = pi < 3 ? 0 : (pi < 5 ? 1 : 2); const int b = pi < 3 ? pi + 1 : (pi < 5 ? pi - 1 : 3); ea = g * 4 + a; eb = g * 4 + b; }
__device__ __forceinline__ void final_phase(const Ctx& c) {
    const float* fw = inp(c, 18);
    for (int o = c.wg * 8 + c.wave; o < NB * SEQ; o += c.G * 8) {
        const int b = o >> 11, sidx = o & 2047, row = row_of(b, sidx + NMETA);
        const float rstd = rsqrtf(ss_row(c.SS, row) * (1.0f / DM) + EPS);
#pragma unroll
        for (int i = 0; i < 4; ++i) { const int col = c.lane * 4 + 256 * i; const f32x4 v = *(const f32x4*)(c.H + (size_t)row * DM + col), wv = *(const f32x4*)(fw + col);
            *(f32x4*)(c.out + (size_t)o * DM + col) = v * rstd * wv; }
    }
}
namespace og {
constexpr int BM = 256, BK = 64, HALF = 128, HTB = HALF * BK * 2, STAGE_BYTES = 8 * HTB;
__device__ __forceinline__ int lds_byte(int r, int c) { const int st = (r >> 4) * 2 + (c >> 5), rr = r & 15, cc = c & 31, ob = rr * 64 + cc * 2; return st * 1024 + (ob ^ (((ob >> 9) & 1) << 5)); }
__device__ __forceinline__ void stage_rc(int b, int& R, int& C) { const int st = b / 1024, sb = b % 1024, swz = sb ^ (((sb >> 9) & 1) << 5); R = (st >> 1) * 16 + swz / 64; C = (st & 1) * 32 + (swz % 64) / 2; }
__device__ __forceinline__ int perm32(int rho) { const int n = rho >> 4, i = rho & 15; return 8 * (i >> 2) + 4 * n + (i & 3); }
__device__ __forceinline__ unsigned cvt_pk_bf16(float lo, float hi) { unsigned r; asm volatile("v_cvt_pk_bf16_f32 %0, %1, %2" : "=v"(r) : "v"(lo), "v"(hi)); return r; }

struct UD { const char* A; const char* B; const int* gl; int gvalid; int mid; int p0, p1, p2, p3; };

typedef f32x4 Acc[2][2][4][2];

template <class Epi, class Sched, bool GATHER>
__device__ __forceinline__ void gemm_run(LAS unsigned char* lds, const Sched& S, const Epi& E, const unsigned lda, const unsigned ldb, const int nt) {
    int tid = threadIdx.x; asm volatile("" : "+v"(tid));
    const int wid = __builtin_amdgcn_readfirstlane(tid >> 6), lane = tid & 63, wr = wid >> 2, wc = wid & 3, fr = lane & 15, fq = lane >> 4;
    unsigned voffB[2];
#pragma unroll
    for (int i = 0; i < 2; ++i) { int R, C; stage_rc(tid * 16 + i * 8192, R, C); const int Rb = (R & ~31) + perm32(R & 31); voffB[i] = (unsigned)Rb * ldb + (unsigned)C * 2u; }
    const size_t kstep = (size_t)(BK * 2);
    const size_t hstepB = (size_t)HALF * ldb;
    const size_t hstepA = GATHER ? (size_t)0 : (size_t)HALF * lda;
    const unsigned ldsw = (unsigned)wid * 1024u;
    const int aoff = lds_byte(wr * 64 + fr, fq * 8), boff = lds_byte(wc * 32 + fr, fq * 8);
#define OG_SA(b, h) (((b) * 2 + (h)) * HTB)
#define OG_SB(b, h) ((4 + (b) * 2 + (h)) * HTB)
#define OG_STAGE(bufoff, gbase, voff) do { _Pragma("unroll") for (int _i = 0; _i < 2; ++_i) \
        __builtin_amdgcn_global_load_lds((const unsigned*)((const char*)(gbase) + (voff)[_i]), (LAS unsigned*)(lds + (bufoff) + ldsw + _i * 8192), 16, 0, 0); } while (0)
#define OG_LDA(dst, b, h) do { _Pragma("unroll") for (int m = 0; m < 4; ++m) _Pragma("unroll") for (int k = 0; k < 2; ++k) dst[m][k] = *(const LAS bf16x8*)(lds + OG_SA(b, h) + aoff + m * 2048 + k * 1024); } while (0)
#define OG_LDB(dst, b, h) do { _Pragma("unroll") for (int n = 0; n < 2; ++n) _Pragma("unroll") for (int k = 0; k < 2; ++k) dst[n][k] = *(const LAS bf16x8*)(lds + OG_SB(b, h) + boff + n * 2048 + k * 1024); } while (0)
#define OG_MMA(ai, bj, At, Bt) do { __builtin_amdgcn_s_setprio(1); _Pragma("unroll") for (int m = 0; m < 4; ++m) _Pragma("unroll") for (int n = 0; n < 2; ++n) _Pragma("unroll") for (int k = 0; k < 2; ++k) \
        acc[ai][bj][m][n] = __builtin_amdgcn_mfma_f32_16x16x32_bf16(Bt[n][k], At[m][k], acc[ai][bj][m][n], 0, 0, 0); __builtin_amdgcn_s_setprio(0); } while (0)
#define OG_WAIT_V(n) asm volatile("s_waitcnt vmcnt(" #n ")" ::: "memory")
#define OG_WAIT_L(n) asm volatile("s_waitcnt lgkmcnt(" #n ")" ::: "memory")
#define OG_BAR __builtin_amdgcn_s_barrier()
#define OG_SCHED __builtin_amdgcn_sched_barrier(0)
#define OG_SETOFF(dst, u) do { int _t = threadIdx.x; asm volatile("" : "+v"(_t)); _Pragma("unroll") for (int _i = 0; _i < 2; ++_i) { int _R, _C; stage_rc(_t * 16 + _i * 8192, _R, _C); \
        _Pragma("unroll") for (int _h = 0; _h < 2; ++_h) { const int _r = _h * HALF + _R; \
        int _row = _r; if (GATHER) _row = (u).gl[_r < (u).gvalid ? _r : 0]; dst[_h][_i] = (unsigned)_row * lda + (unsigned)_C * 2u; } } } while (0)
    UD cur, nxt; int ui = 0;
    if (!S.get(0, cur)) return;
    Acc acc;
    { float z0 = 0.f; asm volatile("" : "+v"(z0));
#pragma unroll
    for (int a = 0; a < 2; ++a)
#pragma unroll
        for (int b = 0; b < 2; ++b)
#pragma unroll
            for (int m = 0; m < 4; ++m)
#pragma unroll
                for (int n = 0; n < 2; ++n) acc[a][b][m][n] = (f32x4){z0, z0, z0, z0}; }
    bf16x8 At[4][2], B0[2][2], B1[2][2];
    unsigned oA[2][2], oN[2][2];
    OG_SETOFF(oA, cur);
    const char* cA = cur.A; const char* cB = cur.B;
    OG_STAGE(OG_SB(0, 0), cB, voffB); OG_STAGE(OG_SB(0, 1), cB + hstepB, voffB); OG_STAGE(OG_SA(0, 0), cA, oA[0]); OG_STAGE(OG_SA(0, 1), cA + hstepA, oA[GATHER ? 1 : 0]);
    if (wr == 1) OG_BAR;
    OG_WAIT_V(2); OG_BAR;
    OG_STAGE(OG_SB(1, 0), cB + kstep, voffB); OG_STAGE(OG_SA(1, 0), cA + kstep, oA[0]); OG_STAGE(OG_SB(1, 1), cB + hstepB + kstep, voffB);
    OG_WAIT_V(6); OG_BAR;
    for (;;) {
        const bool has_next = S.get(ui + 1, nxt);
        const char* nA = has_next ? nxt.A : cA; const char* nB = has_next ? nxt.B : cB;
        if (GATHER) { if (has_next) { OG_SETOFF(oN, nxt); } else {
#pragma unroll
            for (int h = 0; h < 2; ++h)
#pragma unroll
                for (int i = 0; i < 2; ++i) oN[h][i] = oA[h][i]; } }
#pragma unroll 1
        for (int t = 0; t < nt; t += 2) {
            const bool last = (t == nt - 2);
            const char* a1 = cA + (size_t)(t + 1) * kstep;
            const char* a2 = last ? nA : cA + (size_t)(t + 2) * kstep; const char* b2 = last ? nB : cB + (size_t)(t + 2) * kstep;
            const char* a3 = a2 + kstep; const char* b3 = b2 + kstep;
            unsigned o2[2][2];
#pragma unroll
            for (int h = 0; h < 2; ++h)
#pragma unroll
                for (int i = 0; i < 2; ++i) o2[h][i] = (GATHER && last) ? oN[h][i] : oA[h][i];
            OG_LDB(B0, 0, 0); OG_LDB(B1, 0, 1); OG_SCHED; OG_LDA(At, 0, 0); OG_STAGE(OG_SA(1, 1), a1 + hstepA, oA[GATHER ? 1 : 0]);
            OG_WAIT_V(8); OG_WAIT_L(0); OG_BAR; OG_MMA(0, 0, At, B0); OG_MMA(0, 1, At, B1); OG_BAR; OG_SCHED;
            OG_LDA(At, 0, 1); OG_STAGE(OG_SB(0, 0), b2, voffB); OG_STAGE(OG_SB(0, 1), b2 + hstepB, voffB); OG_STAGE(OG_SA(0, 0), a2, o2[0]);
            OG_WAIT_V(8); OG_WAIT_L(0); OG_BAR; OG_MMA(1, 0, At, B0); OG_MMA(1, 1, At, B1); OG_BAR; OG_SCHED;
            OG_LDB(B0, 1, 0); OG_LDB(B1, 1, 1); OG_SCHED; OG_LDA(At, 1, 0); OG_STAGE(OG_SA(0, 1), a2 + hstepA, o2[GATHER ? 1 : 0]);
            OG_WAIT_V(8); OG_WAIT_L(0); OG_BAR; OG_MMA(0, 0, At, B0); OG_MMA(0, 1, At, B1); OG_BAR; OG_SCHED;
            OG_LDA(At, 1, 1); OG_STAGE(OG_SB(1, 0), b3, voffB); OG_STAGE(OG_SB(1, 1), b3 + hstepB, voffB); OG_STAGE(OG_SA(1, 0), a3, o2[0]);
            OG_WAIT_V(8); OG_WAIT_L(0); OG_BAR; OG_MMA(1, 0, At, B0); OG_MMA(1, 1, At, B1); OG_BAR; OG_SCHED;
        }
        const bool ep_now = !(Epi::MID_EMPTY && cur.mid);
        if (ep_now && wr == 0) OG_BAR;
#ifdef PROBE_EPI
        unsigned long long pe_t0 = 0ull; if (blockIdx.x == 0) pe_t0 = wall_clock64();
#endif
        { int t2 = threadIdx.x; asm volatile("" : "+v"(t2));
          const int w2 = __builtin_amdgcn_readfirstlane(t2 >> 6), wr2 = w2 >> 2, wc2 = w2 & 3, fr2 = t2 & 15, fq2 = (t2 >> 4) & 3;
          if constexpr (Epi::UNIFIED) { E.uni(acc, cur, wr2, wc2, fr2, fq2); }
          else { if (cur.mid) { E.mid(acc, cur, wr2, wc2, fr2, fq2); } else { E(acc, cur, wr2, wc2, fr2, fq2); } } }
#ifdef PROBE_EPI
        if (blockIdx.x == 0 && threadIdx.x == 0) { volatile LAS unsigned long long* pa = (volatile LAS unsigned long long*)(lds + MISC_OFF + 32); if (pa[1] != 0ull) { asm volatile("s_waitcnt vmcnt(0)" ::: "memory"); pa[0] += wall_clock64() - pe_t0; } }
#endif
        if (!has_next) break;
        if (!cur.mid) { float z0 = 0.f; asm volatile("" : "+v"(z0));
#pragma unroll
            for (int a = 0; a < 2; ++a)
#pragma unroll
                for (int b = 0; b < 2; ++b)
#pragma unroll
                    for (int m = 0; m < 4; ++m)
#pragma unroll
                        for (int n = 0; n < 2; ++n) acc[a][b][m][n] = (f32x4){z0, z0, z0, z0};
        }
        cur = nxt; cA = nA; cB = nB; ++ui;
        if (GATHER) {
#pragma unroll
            for (int h = 0; h < 2; ++h)
#pragma unroll
                for (int i = 0; i < 2; ++i) oA[h][i] = oN[h][i]; }
        if (ep_now && wr == 1) OG_BAR;
    }
    OG_WAIT_V(0);
    OG_BAR;
#undef OG_SA
#undef OG_SB
#undef OG_STAGE
#undef OG_LDA
#undef OG_LDB
#undef OG_MMA
#undef OG_WAIT_V
#undef OG_WAIT_L
#undef OG_BAR
#undef OG_SCHED
#undef OG_SETOFF
}

__device__ __forceinline__ void grid_tile(int L, int nM, int nN, int& pm, int& pn) {
    const int nwg = nM * nN; int wgid = L; { const int q = nwg / 8, r = nwg % 8, xcd = wgid % 8, off = wgid / 8; wgid = (xcd < r ? xcd * (q + 1) : r * (q + 1) + (xcd - r) * q) + off; }
    const int nig = 8 * nN, gid = wgid / nig, fm = gid * 8, gsz = (nM - fm) < 8 ? (nM - fm) : 8;
    pm = fm + ((wgid % nig) % gsz); pn = (wgid % nig) / gsz;
}
#define OG_ROWS for (int ai = 0; ai < 2; ++ai) _Pragma("unroll") for (int m = 0; m < 4; ++m)
__device__ __forceinline__ int og_row(int cst, int base) { int v = cst; asm volatile("" : "+v"(v)); return v + base; }
#define OG_ROW og_row(ai * 128 + m * 16, wr * 64 + fr)
#define OG_COL(bj) ((bj) * 128 + wc * 32 + fq * 8)
__device__ __forceinline__ void unpack8(const u32x4 v, float (&f)[8]) {
#pragma unroll
    for (int j = 0; j < 4; ++j) { f[2 * j] = __uint_as_float(v[j] << 16); f[2 * j + 1] = __uint_as_float(v[j] & 0xffff0000u); } }
__device__ __forceinline__ u32x4 pack8(const f32x4 a, const f32x4 b) { u32x4 w; w.x = cvt_pk_bf16(a[0], a[1]); w.y = cvt_pk_bf16(a[2], a[3]); w.z = cvt_pk_bf16(b[0], b[1]); w.w = cvt_pk_bf16(b[2], b[3]); return w; }

struct SchedP1 { const char* A; const char* B; int nM, G, wg;
    __device__ __forceinline__ bool get(int i, UD& u) const { const int L = i * G + wg; if (L >= nM * 26) return false; int pm, pn; grid_tile(L, nM, 26, pm, pn);
        u.A = A + (size_t)pm * 256 * 2048; u.B = B + (size_t)pn * 256 * 2048; u.gl = nullptr; u.gvalid = 0; u.mid = 0; u.p0 = pm; u.p1 = pn; u.p2 = 0; u.p3 = 0; return true; } };
struct EpiP1 { static constexpr bool UNIFIED = false, MID_EMPTY = false; bf16_t* Z; const float* SS; const float* b_gate;
    __device__ __forceinline__ void mid(Acc&, const UD&, int, int, int, int) const {}
    __device__ __forceinline__ void operator()(const Acc& acc, const UD& u, int wr, int wc, int fr, int fq) const {
        const int pm = u.p0, pn = u.p1; const int kind = (pn < 8) ? 0 : (pn < 12) ? 1 : (pn < 14) ? 2 : (pn < 18) ? 0 : 3;
        float bg[2][8];
#pragma unroll
        for (int bj = 0; bj < 2; ++bj)
#pragma unroll
            for (int j = 0; j < 8; ++j) bg[bj][j] = 0.f;
        if (kind == 2) {
#pragma unroll
            for (int bj = 0; bj < 2; ++bj) { const float* bp = b_gate + (pn - 12) * 256 + OG_COL(bj); const f32x4 x0 = *(const f32x4*)bp, x1 = *(const f32x4*)(bp + 4);
#pragma unroll
                for (int j = 0; j < 4; ++j) { bg[bj][j] = x0[j]; bg[bj][4 + j] = x1[j]; } } }
#pragma unroll
        OG_ROWS { const int row = pm * 256 + OG_ROW;
            float ssum; { const f32x4 pv = *(const f32x4*)(SS + (size_t)row * 16 + 4 * fq); ssum = (pv[0] + pv[1]) + (pv[2] + pv[3]); ssum += shx<16>(ssum); ssum = xsum32(ssum); }
            const float rstd = rsqrtf(ssum * (1.0f / DM) + EPS);
#pragma unroll
            for (int bj = 0; bj < 2; ++bj) { f32x4 v0 = acc[ai][bj][m][0] * rstd, v1 = acc[ai][bj][m][1] * rstd;
                if (kind == 1) {
#pragma unroll
                    for (int j = 0; j < 4; ++j) { v0[j] = siluf_(v0[j]); v1[j] = siluf_(v1[j]); } }
                else if (kind == 2) {
#pragma unroll
                    for (int j = 0; j < 4; ++j) { v0[j] = logsigmoidf_(v0[j] + bg[bj][j]) * 0.0625f; v1[j] = logsigmoidf_(v1[j] + bg[bj][4 + j]) * 0.0625f; } }
                else if (kind == 3) {
#pragma unroll
                    for (int j = 0; j < 4; ++j) { v0[j] = sigmoidf_(v0[j]); v1[j] = sigmoidf_(v1[j]); } }
                *(u32x4*)(Z + (size_t)row * ZC + pn * 256 + OG_COL(bj)) = pack8(v0, v1); } }
    } };
struct SchedP4 { const char* Z; const char* Bg; const char* Bp; int nM, G, wg;
    __device__ __forceinline__ bool get(int i, UD& u) const { const int L = (i >> 1) * G + wg; if (L >= nM * 4) return false; int pm, pn; grid_tile(L, nM, 4, pm, pn); const int part = i & 1;
        u.A = Z + (size_t)pm * 256 * (ZC * 2) + (part ? ZQ * 2 : ZOG * 2); u.B = (part ? Bp : Bg) + (size_t)pn * 256 * 2048; u.gl = nullptr; u.gvalid = 0; u.mid = part ? 0 : 1; u.p0 = pm; u.p1 = pn; u.p2 = 0; u.p3 = 0; return true; } };
struct EpiP4 { static constexpr bool UNIFIED = true, MID_EMPTY = false; bf16_t* Z;
    __device__ __forceinline__ void uni(Acc& acc, const UD& u, int wr, int wc, int fr, int fq) const {
        const int pm = u.p0, pn = u.p1; const bool mid = u.mid != 0;
#pragma unroll
        for (int ai = 0; ai < 2; ++ai) {
            u32x4 gv0[4][2], gv1[4][2]; bf16_t* zp[4];
#pragma unroll
            for (int m = 0; m < 4; ++m) { const int row = pm * 256 + OG_ROW; zp[m] = Z + (size_t)row * ZC + pn * 256 + OG_COL(0);
#pragma unroll
                for (int bj = 0; bj < 2; ++bj) { gv1[m][bj] = *(const u32x4*)(zp[m] + bj * 128 + ZG1); gv0[m][bj] = mid ? *(const u32x4*)(zp[m] + bj * 128 + ZG0) : gv1[m][bj]; } }
#pragma unroll
            for (int m = 0; m < 4; ++m)
#pragma unroll
                for (int bj = 0; bj < 2; ++bj) { float g0[8], g1[8]; unpack8(gv0[m][bj], g0); unpack8(gv1[m][bj], g1); f32x4 v0, v1;
                    if (mid) {
#pragma unroll
                        for (int j = 0; j < 4; ++j) { v0[j] = acc[ai][bj][m][0][j] * (g0[j] * __builtin_amdgcn_rcpf(fmaxf(g1[j], 1e-30f))); v1[j] = acc[ai][bj][m][1][j] * (g0[4 + j] * __builtin_amdgcn_rcpf(fmaxf(g1[4 + j], 1e-30f))); }
                    } else {
#pragma unroll
                        for (int j = 0; j < 4; ++j) { v0[j] = acc[ai][bj][m][0][j] * fmaxf(g1[j], 1e-30f); v1[j] = acc[ai][bj][m][1][j] * fmaxf(g1[4 + j], 1e-30f); } }
                    acc[ai][bj][m][0] = v0; acc[ai][bj][m][1] = v1;
                    if (!mid) *(u32x4*)(zp[m] + bj * 128 + ZV) = pack8(v0, v1); }
            asm volatile("" ::: "memory"); }
    } };
struct SchedP5 { const char* Z; const char* B; int nM, G, wg;
    __device__ __forceinline__ bool get(int i, UD& u) const { const int L = i * G + wg; if (L >= nM * 4) return false; int pm, pn; grid_tile(L, nM, 4, pm, pn);
        u.A = Z + (size_t)pm * 256 * (ZC * 2) + ZV * 2; u.B = B + (size_t)pn * 256 * 2048; u.gl = nullptr; u.gvalid = 0; u.mid = 0; u.p0 = pm; u.p1 = pn; u.p2 = 0; u.p3 = 0; return true; } };
struct EpiP5 { static constexpr bool UNIFIED = false, MID_EMPTY = false; float* H; bf16_t* HB;
    __device__ __forceinline__ void mid(Acc&, const UD&, int, int, int, int) const {}
    __device__ __forceinline__ void operator()(const Acc& acc, const UD& u, int wr, int wc, int fr, int fq) const {
        const int pm = u.p0, pn = u.p1;
#pragma unroll
        for (int ai = 0; ai < 2; ++ai) {
            f32x4 hv[4][2][2]; float* hp[4];
#pragma unroll
            for (int m = 0; m < 4; ++m) { const int row = pm * 256 + OG_ROW; hp[m] = H + (size_t)row * DM + pn * 256 + OG_COL(0);
#pragma unroll
                for (int bj = 0; bj < 2; ++bj) { hv[m][bj][0] = *(const f32x4*)(hp[m] + bj * 128); hv[m][bj][1] = *(const f32x4*)(hp[m] + bj * 128 + 4); } }
#pragma unroll
            for (int m = 0; m < 4; ++m)
#pragma unroll
                for (int bj = 0; bj < 2; ++bj) { const f32x4 h0 = hv[m][bj][0] + acc[ai][bj][m][0], h1 = hv[m][bj][1] + acc[ai][bj][m][1]; *(f32x4*)(hp[m] + bj * 128) = h0; *(f32x4*)(hp[m] + bj * 128 + 4) = h1;
                    *(u32x4*)(HB + (hp[m] - H) + bj * 128) = pack8(h0, h1); }
            asm volatile("" ::: "memory"); }
    } };
struct SchedGU { const char* XN; const char* Bgu; const int* LIST; MoeTab mt; int G, wg;
    __device__ __forceinline__ bool get(int i, UD& u) const { const int L = i * G + wg; if (L >= mt.ntiles * 8) return false; const int ct = L >> 3, sel = (L >> 2) & 1, pn = L & 3;
        const int cls = __builtin_amdgcn_readfirstlane(mt.cls[ct]), til = __builtin_amdgcn_readfirstlane(mt.til[ct]), cnt = __builtin_amdgcn_readfirstlane(mt.cntv[cls]); int ea, eb; cls_experts(cls, ea, eb); const int e = sel ? eb : ea;
        u.A = XN; u.B = Bgu + (size_t)e * 2097152 + (size_t)pn * 256 * 2048; u.gl = LIST + (size_t)cls * T + 256 * til; u.gvalid = min(256, cnt - 256 * til); u.mid = 0;
        u.p0 = ct; u.p1 = pn; u.p2 = sel; u.p3 = cls * T + 256 * til; return true; } };
struct EpiGU { static constexpr bool UNIFIED = false, MID_EMPTY = false; bf16_t* HID; const float* WTS;
    __device__ __forceinline__ void mid(Acc&, const UD&, int, int, int, int) const {}
    __device__ __forceinline__ void operator()(const Acc& acc, const UD& u, int wr, int wc, int fr, int fq) const {
        const int ct = u.p0, pn = u.p1, sel = u.p2;
#pragma unroll
        OG_ROWS { const int r = OG_ROW; f32x4 wv4 = (f32x4){0.f, 0.f, 0.f, 0.f}; if (r < u.gvalid) wv4 = *(const f32x4*)(WTS + ((size_t)u.p3 + r) * 4);
            const float rs = wv4[2], wt = (sel ? wv4[1] : wv4[0]) * rs; f32x4 v0, v1;
#pragma unroll
            for (int j = 0; j < 4; ++j) { v0[j] = siluf_(acc[ai][0][m][0][j] * rs) * acc[ai][1][m][0][j] * wt; v1[j] = siluf_(acc[ai][0][m][1][j] * rs) * acc[ai][1][m][1][j] * wt; }
            *(u32x4*)(HID + ((size_t)ct * 256 + r) * 1024 + sel * 512 + pn * 128 + wc * 32 + fq * 8) = pack8(v0, v1); }
    } };
struct SchedDN { const char* HID; const char* Bdn; const int* LIST; MoeTab mt; int G, wg;
    __device__ __forceinline__ bool get(int i, UD& u) const { const int L = (i >> 1) * G + wg; if (L >= mt.ntiles * 4) return false; const int ct = L >> 2, pn = L & 3, part = i & 1;
        const int cls = __builtin_amdgcn_readfirstlane(mt.cls[ct]), til = __builtin_amdgcn_readfirstlane(mt.til[ct]), cnt = __builtin_amdgcn_readfirstlane(mt.cntv[cls]); int ea, eb; cls_experts(cls, ea, eb); const int e = part ? eb : ea;
        u.A = HID + (size_t)ct * 256 * 2048 + part * 1024; u.B = Bdn + (size_t)e * 1048576 + (size_t)pn * 256 * 1024; u.gl = LIST + (size_t)cls * T + 256 * til; u.gvalid = min(256, cnt - 256 * til); u.mid = part ? 0 : 1;
        u.p0 = ct; u.p1 = pn; u.p2 = 0; u.p3 = 0; return true; } };
struct EpiDN { static constexpr bool UNIFIED = false, MID_EMPTY = true; float* H; bf16_t* HB; float* SS; int write_hb;
    __device__ __forceinline__ void mid(Acc&, const UD&, int, int, int, int) const {}
    __device__ __forceinline__ void operator()(const Acc& acc, const UD& u, int wr, int wc, int fr, int fq) const {
        const int pn = u.p1;
        int tok[2][4];
#pragma unroll
        for (int ai = 0; ai < 2; ++ai)
#pragma unroll
            for (int m = 0; m < 4; ++m) { const int r = OG_ROW; tok[ai][m] = (r < u.gvalid) ? u.gl[r] : -1; }
#pragma unroll
        for (int ai = 0; ai < 2; ++ai) {
            f32x4 hv[4][2][2];
#pragma unroll
            for (int m = 0; m < 4; ++m) { const size_t off = (size_t)(tok[ai][m] < 0 ? 0 : tok[ai][m]) * DM + pn * 256 + OG_COL(0);
#pragma unroll
                for (int bj = 0; bj < 2; ++bj) { hv[m][bj][0] = *(const f32x4*)(H + off + bj * 128); hv[m][bj][1] = *(const f32x4*)(H + off + bj * 128 + 4); } }
#pragma unroll
            for (int m = 0; m < 4; ++m) { const bool ok = tok[ai][m] >= 0; const size_t off = (size_t)(ok ? tok[ai][m] : 0) * DM + pn * 256 + OG_COL(0); float sq = 0.f;
#pragma unroll
                for (int bj = 0; bj < 2; ++bj) { const f32x4 h0 = hv[m][bj][0] + acc[ai][bj][m][0], h1 = hv[m][bj][1] + acc[ai][bj][m][1];
                    if (ok) { *(f32x4*)(H + off + bj * 128) = h0; *(f32x4*)(H + off + bj * 128 + 4) = h1; if (write_hb) *(u32x4*)(HB + off + bj * 128) = pack8(h0, h1); }
                    sq += h0[0] * h0[0] + h0[1] * h0[1] + h0[2] * h0[2] + h0[3] * h0[3] + h1[0] * h1[0] + h1[1] * h1[1] + h1[2] * h1[2] + h1[3] * h1[3]; }
                sq += shx<16>(sq); sq = xsum32(sq);
                if (ok && fq == 0) SS[(size_t)tok[ai][m] * 16 + pn * 4 + wc] = sq; }
            asm volatile("" ::: "memory"); }
    } };
}

template <int KIND> __device__ __forceinline__ void tail_phase(const Ctx& c, const LayerW& w, int segbase);
__device__ __forceinline__ void p1_opt(const Ctx& c, const LayerW& w, int segbase, int segrows) {
    og::SchedP1 S{(const char*)(c.HB + (size_t)segbase * DM), (const char*)w.Bin, segrows / 256, c.G, c.wg}; og::EpiP1 E{c.Z, c.SS + (size_t)segbase * 16, w.b_gate};
    og::gemm_run<og::EpiP1, og::SchedP1, false>(c.lds, S, E, 2048u, 2048u, 16);
}
__device__ __forceinline__ void p4_opt(const Ctx& c, const LayerW& w, int segrows) {
    const bool tail = (segrows / 256 == 65);
    og::SchedP4 S{(const char*)c.Z, (const char*)w.Bbrg, (const char*)w.Bbrp, tail ? 64 : segrows / 256, c.G, c.wg}; og::EpiP4 E{c.Z};
    og::gemm_run<og::EpiP4, og::SchedP4, false>(c.lds, S, E, (unsigned)(ZC * 2), 2048u, 16);
    if (tail) tail_phase<4>(c, w, 0);
}
__device__ __forceinline__ void p5_opt(const Ctx& c, const LayerW& w, int segbase, int segrows) {
    const bool tail = (segrows / 256 == 65);
    og::SchedP5 S{(const char*)c.Z, (const char*)w.Bout, tail ? 64 : segrows / 256, c.G, c.wg}; og::EpiP5 E{c.H + (size_t)segbase * DM, c.HB + (size_t)segbase * DM};
    og::gemm_run<og::EpiP5, og::SchedP5, false>(c.lds, S, E, (unsigned)(ZC * 2), 2048u, 16);
    if (tail) tail_phase<5>(c, w, segbase);
}
__device__ __forceinline__ void gu_opt(const Ctx& c, const LayerW& w, int layer) {
    const MoeTab mt = moe_table(c, layer);
    const int vwg = (c.G % 8 == 0) ? (c.wg & 7) * (c.G >> 3) + (c.wg >> 3) : c.wg;
    og::SchedGU S{(const char*)c.HB, (const char*)w.Bgu, (const int*)((const unsigned char*)c.Z + MZ_LIST), mt, c.G, vwg};
    og::EpiGU E{(bf16_t*)((unsigned char*)c.Z + MZ_HID), (const float*)((const unsigned char*)c.Z + MZ_WTS)};
    og::gemm_run<og::EpiGU, og::SchedGU, true>(c.lds, S, E, 2048u, 2048u, 16);
}
__device__ __forceinline__ void dn_opt(const Ctx& c, const LayerW& w, int layer) {
    const MoeTab mt = moe_table(c, layer);
    const int vwg = (c.G % 8 == 0) ? (c.wg & 7) * (c.G >> 3) + (c.wg >> 3) : c.wg;
    og::SchedDN S{(const char*)c.Z + MZ_HID, (const char*)w.Bdn, (const int*)((const unsigned char*)c.Z + MZ_LIST), mt, c.G, vwg};
    og::EpiDN E{c.H, c.HB, c.SS, layer == 0 ? 1 : 0};
    og::gemm_run<og::EpiDN, og::SchedDN, false>(c.lds, S, E, 2048u, 1024u, 8);
}
__device__ __forceinline__ void chunk_rows(int seg, int b, int ch, int& r0, int& nvalid) {
    if (seg == 0) { if (ch == 0) { r0 = b * SEG0_LEN; nvalid = 16; } else { r0 = b * SEG0_LEN + 16 + 64 * (ch - 1); nvalid = 64; } }
    else { r0 = b * SEG1_LEN + 64 * (ch - 17); nvalid = 64; }
}
__device__ __forceinline__ void gla_opt(const Ctx& c, int seg) {
    constexpr int STQ = 272, STT = 144;
    LAS unsigned char* const L = c.lds;
    LAS unsigned char* const QE = L; LAS unsigned char* const QI = L + 17408; LAS unsigned char* const KE = L + 34816; LAS unsigned char* const KI = L + 52224;
    LAS unsigned char* const KDT = L + 69632; LAS unsigned char* const VT = L + 88064; LAS unsigned char* const ATT = L + 97280;
    LAS float* const PART = (LAS float*)(L + 106496); LAS float* const EG = (LAS float*)(L + 110592); LAS unsigned char* const OP = L + 111104;
    const int lane = c.lane, w = c.wave, fr = lane & 15, g = lane >> 4, vt = w & 3, chh = w >> 2;
    const float LOG2E = 1.4426950408889634f;
    float* stsave = (float*)(c.ws + WS_STATE);
    for (int cw = c.wg; cw < 256; cw += c.G) {
        const int chain = (cw & 7) * 32 + (cw >> 3);
        const int b = chain >> 4, h = (chain >> 2) & 3, s = chain & 3;
        f32x4 S0, S1, S2, S3;
        if (seg == 0) { S0 = (f32x4){0.f, 0.f, 0.f, 0.f}; S1 = S0; S2 = S0; S3 = S0; }
        else { const f32x4* sp = (const f32x4*)(stsave + ((size_t)chain * 512 + c.tid) * 16); S0 = sp[0]; S1 = sp[1]; S2 = sp[2]; S3 = sp[3]; }
        const int c_lo = seg == 0 ? 0 : 17, c_hi = seg == 0 ? 17 : 33;
        unsigned q2[8], k2[8], g2[8]; u32x4 vraw;
#define GLA_LOAD(chk) do { int r0_, nv_; chunk_rows(seg, b, (chk), r0_, nv_); const char* zb_ = (const char*)c.Z + (size_t)r0_ * (ZC * 2); \
        _Pragma("unroll") for (int i = 0; i < 8; ++i) { const int row_ = 8 * w + i; const bool ok_ = row_ < nv_; const char* p_ = zb_ + (size_t)(ok_ ? row_ : 0) * (ZC * 2);     \
            const unsigned a_ = *(const unsigned*)(p_ + ZQ * 2 + loff), b_ = *(const unsigned*)(p_ + ZK * 2 + loff), c_ = *(const unsigned*)(p_ + ZG * 2 + loff); \
            q2[i] = a_; k2[i] = b_; g2[i] = c_; } \
        { const bool okv_ = lane < nv_; const u32x4 v_ = *(const u32x4*)(zb_ + (size_t)((okv_ ? (unsigned)lane : 0u) * (unsigned)(ZC * 2) + voff)); \
          vraw = v_; } } while (0)
        const unsigned loff = (unsigned)(h * 128 + 2 * lane) * 2u, voff = (unsigned)(ZV + h * 256 + s * 64 + 8 * w) * 2u;
        GLA_LOAD(c_lo);
        for (int chk = c_lo; chk < c_hi; ++chk) {
            int r0, nvalid; chunk_rows(seg, b, chk, r0, nvalid);
            if (nvalid < 64) {
#pragma unroll
                for (int i = 0; i < 8; ++i) { const bool ok = 8 * w + i < nvalid; q2[i] = ok ? q2[i] : 0u; k2[i] = ok ? k2[i] : 0u; g2[i] = ok ? g2[i] : 0u; }
                if (lane >= nvalid) vraw = (u32x4){0u, 0u, 0u, 0u}; }
            float cl0[8], cl1[8]; { float a0 = 0.f, a1 = 0.f;
#pragma unroll
                for (int i = 0; i < 8; ++i) { a0 += bflo(g2[i]); a1 += bfhi(g2[i]); cl0[i] = a0; cl1[i] = a1; }
                *(LAS f32x2*)(PART + w * 128 + 2 * lane) = (f32x2){a0, a1}; }
            __syncthreads();
            float p0 = 0.f, p1 = 0.f, t0 = 0.f, t1 = 0.f;
#pragma unroll
            for (int r = 0; r < 8; ++r) { const f32x2 x = *(const LAS f32x2*)(PART + r * 128 + 2 * lane); t0 += x[0]; t1 += x[1]; if (r < w) { p0 += x[0]; p1 += x[1]; } }
            const float eg0 = __builtin_amdgcn_exp2f(t0 * LOG2E), eg1 = __builtin_amdgcn_exp2f(t1 * LOG2E);
            if (w == 0) *(LAS f32x2*)(EG + 2 * lane) = (f32x2){eg0, eg1};
            unsigned kd0[4], kd1[4]; float dprev0 = 0.f, dprev1 = 0.f;
#pragma unroll
            for (int i = 0; i < 8; ++i) {
                const float b0 = (p0 + cl0[i]) * LOG2E, b1 = (p1 + cl1[i]) * LOG2E;
                const float e0 = __builtin_amdgcn_exp2f(b0), e1 = __builtin_amdgcn_exp2f(b1), ie0 = __builtin_amdgcn_exp2f(-b0), ie1 = __builtin_amdgcn_exp2f(-b1);
                const float qa = bflo(q2[i]), qb = bfhi(q2[i]), ka = bflo(k2[i]), kb = bfhi(k2[i]);
                const int ro = (8 * w + i) * STQ + 4 * lane;
                *(LAS unsigned*)(QE + ro) = og::cvt_pk_bf16(qa * e0, qb * e1); *(LAS unsigned*)(QI + ro) = og::cvt_pk_bf16(qa * ie0, qb * ie1);
                *(LAS unsigned*)(KE + ro) = og::cvt_pk_bf16(ka * e0, kb * e1); *(LAS unsigned*)(KI + ro) = og::cvt_pk_bf16(ka * ie0, kb * ie1);
                const float d0 = ka * ie0 * eg0, d1 = kb * ie1 * eg1;
                if (i & 1) { kd0[i >> 1] = og::cvt_pk_bf16(dprev0, d0); kd1[i >> 1] = og::cvt_pk_bf16(dprev1, d1); } else { dprev0 = d0; dprev1 = d1; }
            }
            *(LAS u32x4*)(KDT + (2 * lane) * STT + w * 16) = (u32x4){kd0[0], kd0[1], kd0[2], kd0[3]};
            *(LAS u32x4*)(KDT + (2 * lane + 1) * STT + w * 16) = (u32x4){kd1[0], kd1[1], kd1[2], kd1[3]};
#pragma unroll
            for (int j = 0; j < 4; ++j) { *(LAS bf16_t*)(VT + (8 * w + 2 * j) * STT + 2 * lane) = (bf16_t)(vraw[j] & 0xffffu); *(LAS bf16_t*)(VT + (8 * w + 2 * j + 1) * STT + 2 * lane) = (bf16_t)(vraw[j] >> 16); }
            if (chk + 1 < c_hi) { GLA_LOAD(chk + 1); }
            __syncthreads();
            { const int it = w >> 1;
#pragma unroll
              for (int tj = 0; tj < 2; ++tj) { const int jt = 2 * (w & 1) + tj;
                f32x4 lo = (f32x4){0.f, 0.f, 0.f, 0.f}, up = lo;
                if (it >= jt) {
#pragma unroll
                    for (int kb = 0; kb < 4; ++kb) { const bf16x8 a = *(const LAS bf16x8*)(QE + (16 * it + fr) * STQ + (32 * kb + 8 * g) * 2), bb = *(const LAS bf16x8*)(KI + (16 * jt + fr) * STQ + (32 * kb + 8 * g) * 2);
                        lo = __builtin_amdgcn_mfma_f32_16x16x32_bf16(a, bb, lo, 0, 0, 0); } }
                if (it <= jt) {
#pragma unroll
                    for (int kb = 0; kb < 4; ++kb) { const bf16x8 a = *(const LAS bf16x8*)(QI + (16 * it + fr) * STQ + (32 * kb + 8 * g) * 2), bb = *(const LAS bf16x8*)(KE + (16 * jt + fr) * STQ + (32 * kb + 8 * g) * 2);
                        up = __builtin_amdgcn_mfma_f32_16x16x32_bf16(a, bb, up, 0, 0, 0); } }
#pragma unroll
                for (int r = 0; r < 4; ++r) { const int il = 4 * g + r; float v = (it > jt) ? lo[r] : (it < jt) ? up[r] : ((il >= fr) ? lo[r] : up[r]);
                    *(LAS bf16_t*)(ATT + (16 * it + il) * STT + (16 * jt + fr) * 2) = (bf16_t)og::cvt_pk_bf16(v, v); } } }
            f32x4 o0 = (f32x4){0.f, 0.f, 0.f, 0.f}, o1 = o0, o2 = o0, o3 = o0;
#pragma unroll
            for (int kbl = 0; kbl < 2; ++kbl) {
                const f32x4 sa = kbl ? S2 : S0, sb = kbl ? S3 : S1;
                const u32x4 bw = (u32x4){og::cvt_pk_bf16(sa[0], sa[1]), og::cvt_pk_bf16(sa[2], sa[3]), og::cvt_pk_bf16(sb[0], sb[1]), og::cvt_pk_bf16(sb[2], sb[3])};
                bf16x8 bfr; __builtin_memcpy(&bfr, &bw, 16);
                const int cb = (64 * chh + 32 * kbl + 4 * g) * 2;
#define GLA_OI(oacc, itv) do { const u32x2 x0 = *(const LAS u32x2*)(QE + (16 * (itv) + fr) * STQ + cb), x1 = *(const LAS u32x2*)(QE + (16 * (itv) + fr) * STQ + cb + 32); \
                    const u32x4 aw = (u32x4){x0.x, x0.y, x1.x, x1.y}; bf16x8 af; __builtin_memcpy(&af, &aw, 16); oacc = __builtin_amdgcn_mfma_f32_16x16x32_bf16(af, bfr, oacc, 0, 0, 0); } while (0)
                GLA_OI(o0, 0); GLA_OI(o1, 1); GLA_OI(o2, 2); GLA_OI(o3, 3);
            }
#define GLA_SU(Sx, ct) do { const f32x4 ev = *(const LAS f32x4*)(EG + 64 * chh + 16 * (ct) + 4 * g); Sx = Sx * ev; \
                _Pragma("unroll") for (int kb = 0; kb < 2; ++kb) { const bf16x8 a = *(const LAS bf16x8*)(KDT + (64 * chh + 16 * (ct) + fr) * STT + (32 * kb + 8 * g) * 2), bb = *(const LAS bf16x8*)(VT + (16 * vt + fr) * STT + (32 * kb + 8 * g) * 2); \
                    Sx = __builtin_amdgcn_mfma_f32_16x16x32_bf16(a, bb, Sx, 0, 0, 0); } } while (0)
            GLA_SU(S0, 0); GLA_SU(S1, 1); GLA_SU(S2, 2); GLA_SU(S3, 3);
            __syncthreads();
#define GLA_OA(oacc, itv) do { const bf16x8 a = *(const LAS bf16x8*)(ATT + (16 * (itv) + fr) * STT + (32 * chh + 8 * g) * 2), bb = *(const LAS bf16x8*)(VT + (16 * vt + fr) * STT + (32 * chh + 8 * g) * 2); \
                oacc = __builtin_amdgcn_mfma_f32_16x16x32_bf16(a, bb, oacc, 0, 0, 0); } while (0)
            GLA_OA(o0, 0); GLA_OA(o1, 1); GLA_OA(o2, 2); GLA_OA(o3, 3);
            f32x4 m0, m1, x0, x1;
            if (chh) { m0 = o2; m1 = o3; x0 = o0; x1 = o1; } else { m0 = o0; m1 = o1; x0 = o2; x1 = o3; }
            *(LAS f32x4*)(OP + ((vt * 2 + chh) * 2 + 0) * 1024 + lane * 16) = x0; *(LAS f32x4*)(OP + ((vt * 2 + chh) * 2 + 1) * 1024 + lane * 16) = x1;
            __syncthreads();
            m0 += *(const LAS f32x4*)(OP + ((vt * 2 + (1 - chh)) * 2 + 0) * 1024 + lane * 16); m1 += *(const LAS f32x4*)(OP + ((vt * 2 + (1 - chh)) * 2 + 1) * 1024 + lane * 16);
            { char* ob = (char*)c.Z + (size_t)r0 * (ZC * 2); const unsigned oo = (unsigned)(ZV + h * 256 + s * 64 + 16 * vt + fr) * 2u + (unsigned)(32 * chh + 4 * g) * (unsigned)(ZC * 2);
              if (nvalid == 64) {
#pragma unroll
                for (int r = 0; r < 4; ++r) { *(bf16_t*)(ob + (size_t)(oo + (unsigned)r * (ZC * 2))) = (bf16_t)og::cvt_pk_bf16(m0[r], m0[r]); *(bf16_t*)(ob + (size_t)(oo + (unsigned)(16 + r) * (ZC * 2))) = (bf16_t)og::cvt_pk_bf16(m1[r], m1[r]); }
              } else {
#pragma unroll
                for (int r = 0; r < 4; ++r) { const int i0 = 32 * chh + 4 * g + r, i1 = i0 + 16;
                    if (i0 < nvalid) *(bf16_t*)(ob + (size_t)(oo + (unsigned)r * (ZC * 2))) = (bf16_t)og::cvt_pk_bf16(m0[r], m0[r]);
                    if (i1 < nvalid) *(bf16_t*)(ob + (size_t)(oo + (unsigned)(16 + r) * (ZC * 2))) = (bf16_t)og::cvt_pk_bf16(m1[r], m1[r]); } } }
        }
        if (seg == 0) { f32x4* sp = (f32x4*)(stsave + ((size_t)chain * 512 + c.tid) * 16); sp[0] = S0; sp[1] = S1; sp[2] = S2; sp[3] = S3; }
        __syncthreads();
#undef GLA_LOAD
#undef GLA_OI
#undef GLA_SU
#undef GLA_OA
    }
}
template <int KIND>
__device__ __forceinline__ void tail_phase(const Ctx& c, const LayerW& w, int segbase) {
    constexpr int TR0 = 16384;
    LAS float* RED = (LAS float*)c.lds;
    const int lane = c.lane;
    for (int st = c.wg; st < 256; st += c.G) {
        const int m0 = TR0 + (st >> 4) * 16, n0 = (st & 15) * 64;
        f32x4 a1[4], a2[4]; ZERO_ACC(a1); ZERO_ACC(a2);
        if (KIND == 4) { const int kb = c.wave * 128;
            sg_acc_n<4>(a1, c.Z + (size_t)(m0 + (lane & 15)) * ZC + ZOG + kb, w.Bbrg + kb, DM, n0, lane);
            sg_acc_n<4>(a2, c.Z + (size_t)(m0 + (lane & 15)) * ZC + ZQ + kb, w.Bbrp + kb, DM, n0, lane); }
        if (KIND == 5) { const int kb = c.wave * 128;
            sg_acc_n<4>(a1, c.Z + (size_t)(m0 + (lane & 15)) * ZC + ZV + kb, w.Bout + kb, DM, n0, lane); }
        __syncthreads();
#pragma unroll
        for (int j = 0; j < 4; ++j) { *(LAS f32x4*)(RED + (((c.wave * 2 + 0) * 4 + j) * 64 + lane) * 4) = a1[j]; if (KIND == 4) *(LAS f32x4*)(RED + (((c.wave * 2 + 1) * 4 + j) * 64 + lane) * 4) = a2[j]; }
        __syncthreads();
        for (int e = c.tid; e < 1024; e += 512) { const int r = e >> 6, col = e & 63, j = col >> 4, ln = (col & 15) + 16 * (r >> 2), reg = r & 3;
            float s1 = 0.f, s2 = 0.f;
#pragma unroll
            for (int wv = 0; wv < 8; ++wv) { s1 += RED[(((wv * 2 + 0) * 4 + j) * 64 + ln) * 4 + reg]; if (KIND == 4) s2 += RED[(((wv * 2 + 1) * 4 + j) * 64 + ln) * 4 + reg]; }
            const int m = m0 + r, n = n0 + col;
            if (KIND == 4) { bf16_t* zr = c.Z + (size_t)m * ZC; zr[ZV + n] = f2bf(bf2f(zr[ZG0 + n]) * s1 + bf2f(zr[ZG1 + n]) * s2); }
            if (KIND == 5) { const float hv = c.H[(size_t)(segbase + m) * DM + n] + s1; c.H[(size_t)(segbase + m) * DM + n] = hv; c.HB[(size_t)(segbase + m) * DM + n] = f2bf(hv); } }
    }
    __syncthreads();
}
constexpr int N_PHASES = 28;
struct Params { const float* in[19]; float* out; unsigned char* ws; int ph_lo, ph_hi; };
#ifndef ONE_LAUNCH
#define ONE_LAUNCH 1
#endif
__global__ void __launch_bounds__(512, 2) k_fwd(Params p) {
    extern __shared__ __attribute__((aligned(16))) unsigned char lds_raw[];
    Ctx c;
    c.out = p.out; c.ws = p.ws; c.lds = (LAS unsigned char*)lds_raw;
    c.tid = threadIdx.x; c.lane = c.tid & 63; c.wave = __builtin_amdgcn_readfirstlane(c.tid >> 6); c.G = gridDim.x; c.wg = blockIdx.x;
    c.ctl = (unsigned*)(p.ws + WS_CTL); c.H = (float*)(p.ws + WS_H); c.HB = (bf16_t*)(p.ws + WS_HB); c.SS = (float*)(p.ws + WS_SS); c.Z = (bf16_t*)(p.ws + WS_Z);
    volatile LAS unsigned* misc = (volatile LAS unsigned*)(c.lds + MISC_OFF);
    if (c.tid < 16) misc[c.tid] = 0u;
    if (c.tid == 0) {
#pragma unroll
        for (int k = 0; k < 19; ++k) { const unsigned long long a = (unsigned long long)p.in[k]; misc[16 + 2 * k] = (unsigned)a; misc[16 + 2 * k + 1] = (unsigned)(a >> 32); } }
    __syncthreads();
    const int lo = p.ph_lo, hi = p.ph_hi;
    if (hi - lo > 1) (void)xcd_barrier_post(c.ctl + CW_BAR, misc);
#define FRESH() do { w = layer_w(c, l); int t_ = threadIdx.x; asm volatile("" : "+v"(t_)); c.tid = t_; c.lane = t_ & 63; c.wave = __builtin_amdgcn_readfirstlane(t_ >> 6); int g_ = blockIdx.x; asm volatile("" : "+s"(g_)); c.wg = g_; } while (0)
#ifdef PROBE_MASK
    unsigned long long pr_acc = 0ull, pr_t0 = 0ull;
#ifdef PROBE_EPI
#define PR_BEGIN(kind) do { if ((PROBE_MASK >> (kind)) & 1) { if (threadIdx.x == 0) ((volatile LAS unsigned long long*)(c.lds + MISC_OFF + 32))[1] = 1ull; __syncthreads(); } } while (0)
#define PR_END(kind) do { if ((PROBE_MASK >> (kind)) & 1) { __syncthreads(); if (threadIdx.x == 0) ((volatile LAS unsigned long long*)(c.lds + MISC_OFF + 32))[1] = 0ull; __syncthreads(); } } while (0)
#else
#define PR_BEGIN(kind) do { if ((PROBE_MASK >> (kind)) & 1) pr_t0 = wall_clock64(); } while (0)
#define PR_END(kind) do { if ((PROBE_MASK >> (kind)) & 1) pr_acc += wall_clock64() - pr_t0; } while (0)
#endif
#else
#define PR_BEGIN(kind) do { } while (0)
#define PR_END(kind) do { } while (0)
#endif
#define IN(k) (lo <= (k) && (k) < hi)
#define SEAM(k) do { if (IN(k) && IN((k) + 1)) { XcdBarrier b2; b2.bar = (unsigned*)(c.ws + WS_CTL) + CW_BAR; b2.x = xb_xcc_id(); b2.st = (volatile LAS unsigned*)(c.lds + MISC_OFF); xcd_barrier(b2); } } while (0)
    LayerW w; int l = 0;
    PR_BEGIN(0); if (IN(0)) { FRESH(); phase_prep(c); }
    SEAM(0); PR_END(0);
    for (l = 0; l < 2; ++l) {
        const int base = 1 + 13 * l;
        for (int s = 0; s < 2; ++s) {
            const int sb = base + 5 * s, segbase = s ? SEG0_ROWS : 0, segrows = s ? SEG1_ROWS : SEG0_ROWS;
            PR_BEGIN(1); if (IN(sb + 0)) { FRESH(); P1_IMPL(c, w, segbase, segrows); }
            SEAM(sb + 0); PR_END(1);
            PR_BEGIN(2); if (IN(sb + 1)) { FRESH(); P2_IMPL(c, s); }
            SEAM(sb + 1); PR_END(2);
            PR_BEGIN(3); if (IN(sb + 2)) { FRESH(); pool_phase(c, s); FRESH(); ygla_phase(c, w, segrows); }
            SEAM(sb + 2); PR_END(3);
            PR_BEGIN(4); if (IN(sb + 3)) { FRESH(); P4_IMPL(c, w, segrows); }
            SEAM(sb + 3); PR_END(4);
            PR_BEGIN(5); if (IN(sb + 4)) { FRESH(); P5_IMPL(c, w, segbase, segrows); }
            SEAM(sb + 4); PR_END(5);
        }
        PR_BEGIN(6); if (IN(base + 10)) { FRESH(); route_phase(c, w, l); }
        SEAM(base + 10); PR_END(6);
        PR_BEGIN(7); if (IN(base + 11)) { FRESH(); GU_IMPL(c, w, l); }
        SEAM(base + 11); PR_END(7);
        PR_BEGIN(8); if (IN(base + 12)) { FRESH(); DN_IMPL(c, w, l); }
        SEAM(base + 12); PR_END(8);
    }
    l = 1;
    PR_BEGIN(9); if (IN(27)) { FRESH(); final_phase(c); } PR_END(9);
#ifdef PROBE_MASK
#ifdef PROBE_EPI
    __syncthreads(); pr_acc = ((volatile LAS unsigned long long*)(c.lds + MISC_OFF + 32))[0];
#endif
    if (blockIdx.x == 0) { const unsigned long long tend = wall_clock64() + (unsigned long long)PROBE_F * pr_acc; while (wall_clock64() < tend) __builtin_amdgcn_s_sleep(8); }
#endif
#undef IN
#undef SEAM
}

extern "C" void kernel_launch(void* const* d_in, const int* in_sizes, int n_in, void* d_out, int out_size, void* d_ws, size_t ws_size, hipStream_t stream) {
    static int grid = 0;
    if (grid == 0) {
        if (n_in != 19 || out_size != NB * SEQ * DM || ws_size < WS_END) { fprintf(stderr, "kernel_launch: unexpected shapes (n_in %d out %d ws %zu need %zu)\n", n_in, out_size, ws_size, (size_t)WS_END); grid = -1; return; }
        int dev = 0, cus = 0, per_cu = 0;
        if (hipGetDevice(&dev) != hipSuccess || hipDeviceGetAttribute(&cus, hipDeviceAttributeMultiprocessorCount, dev) != hipSuccess) { grid = -1; return; }
        if (hipFuncSetAttribute((const void*)k_fwd, hipFuncAttributeMaxDynamicSharedMemorySize, LDS_BYTES) != hipSuccess) { fprintf(stderr, "kernel_launch: hipFuncSetAttribute failed\n"); grid = -1; return; }
        if (hipOccupancyMaxActiveBlocksPerMultiprocessor(&per_cu, (const void*)k_fwd, 512, LDS_BYTES) != hipSuccess || per_cu < 1) fprintf(stderr, "kernel_launch: occupancy query says %d\n", per_cu);
        (void)hipGetLastError();
        grid = cus;
        if (grid < 65) { fprintf(stderr, "kernel_launch: %d CUs: the router's per-wave record table is sized for 65+ workgroups\n", grid); grid = -1; return; }
    }
    if (grid < 0) return;
    if (hipMemsetAsync((char*)d_ws + WS_CTL, 0, CTL_BYTES, stream) != hipSuccess) return;
    Params p{};
    for (int i = 0; i < 19; ++i) p.in[i] = (const float*)d_in[i];
    p.out = (float*)d_out; p.ws = (unsigned char*)d_ws;
#if ONE_LAUNCH
    p.ph_lo = 0; p.ph_hi = N_PHASES;
    hipLaunchKernelGGL(k_fwd, dim3(grid), dim3(512), LDS_BYTES, stream, p);
#else
    for (int k = 0; k < N_PHASES; ++k) { p.ph_lo = k; p.ph_hi = k + 1; hipLaunchKernelGGL(k_fwd, dim3(grid), dim3(512), LDS_BYTES, stream, p); }
#endif
}
```

```cpp
#define ONE_LAUNCH 1
#define P1_IMPL p1_opt
#define P2_IMPL gla_opt
#define P4_IMPL p4_opt
#define P5_IMPL p5_opt
#define GU_IMPL gu_opt
#define DN_IMPL dn_opt
#include <hip/hip_runtime.h>
#include <stdint.h>
#include <stdio.h>

typedef unsigned short bf16_t;
typedef short bf16x8 __attribute__((ext_vector_type(8)));
typedef float f32x4 __attribute__((ext_vector_type(4)));
typedef float f32x2 __attribute__((ext_vector_type(2)));
typedef unsigned u32x4 __attribute__((ext_vector_type(4)));
typedef unsigned u32x2 __attribute__((ext_vector_type(2)));
#define LAS __attribute__((address_space(3)))

constexpr int DM = 1024, NB = 16, SEQ = 2048, NMETA = 16, LSEQ = SEQ + NMETA, T = NB * LSEQ;
constexpr int SEG0_LEN = 1040, SEG1_LEN = 1024, SEG0_ROWS = NB * SEG0_LEN, SEG1_ROWS = NB * SEG1_LEN;
constexpr int ZC = 6656;
constexpr int ZQ = 0, ZK = 512, ZV = 1024, ZOG = 2048, ZG = 3072, ZU = 3584, ZG0 = 4608, ZG1 = 5632;
constexpr int IN_COLS = 6160;
constexpr int NCLS = 24, MAXCT = 160;
constexpr float EPS = 1e-6f;

constexpr size_t WS_CTL = 0;
constexpr size_t CTL_BYTES = 65536;
constexpr size_t WS_H = WS_CTL + CTL_BYTES;
constexpr size_t WS_HB = WS_H + (size_t)T * DM * 4;
constexpr size_t WS_SS = WS_HB + (size_t)T * DM * 2;
constexpr size_t WS_Z = WS_SS + (size_t)T * 16 * 4;
constexpr size_t Z_BYTES = (size_t)SEG0_ROWS * ZC * 2;
constexpr size_t WS_W0 = WS_Z + Z_BYTES;
constexpr size_t W_IN = 0, W_GRP = W_IN + (size_t)ZC * DM * 2, W_BRG = W_GRP + 4 * 256 * 256 * 2, W_BRP = W_BRG + (size_t)DM * DM * 2, W_OUT = W_BRP + (size_t)DM * DM * 2,
                 W_GU = W_OUT + (size_t)DM * DM * 2, W_DN = W_GU + (size_t)16 * 1024 * 1024 * 2, W_BYTES = W_DN + (size_t)16 * 1024 * 512 * 2;
constexpr size_t WS_STATE = WS_W0 + W_BYTES;
constexpr size_t WS_HALO = WS_STATE + (size_t)256 * 8192 * 4;
constexpr size_t WS_END = WS_HALO + (size_t)16 * 15 * 1024 * 2;
constexpr size_t MZ_HID = 0;
constexpr size_t MZ_LIST = MZ_HID + (size_t)MAXCT * 256 * 1024 * 2;
constexpr size_t MZ_WTS = MZ_LIST + (size_t)NCLS * T * 4;
constexpr size_t MZ_END = MZ_WTS + (size_t)NCLS * T * 16;
static_assert(MZ_END <= Z_BYTES, "MoE buffers must fit the z region");
static_assert(WS_END <= (size_t)536870912, "workspace");
static_assert(W_BYTES <= (size_t)NB * SEQ * DM * 4, "layer-1 weights must fit d_out");
constexpr int CW_BAR = 0;
constexpr int CW_CNT = 4096;
constexpr int CW_TICKET = 8192;

constexpr int LDS_BYTES = 160 * 1024;
constexpr int MISC_OFF = LDS_BYTES - 256;

__device__ __forceinline__ float bf2f(bf16_t v) { return __uint_as_float(((unsigned)v) << 16); }
__device__ __forceinline__ bf16_t f2bf(float f) { unsigned u = __float_as_uint(f); u += 0x7FFFu + ((u >> 16) & 1u); return (bf16_t)(u >> 16); }
__device__ __forceinline__ unsigned pk2(float lo, float hi) { unsigned r; asm volatile("v_cvt_pk_bf16_f32 %0, %1, %2" : "=v"(r) : "v"(lo), "v"(hi)); return r; }
__device__ __forceinline__ float bflo(unsigned u) { return __uint_as_float(u << 16); }
__device__ __forceinline__ float bfhi(unsigned u) { return __uint_as_float(u & 0xffff0000u); }
__device__ __forceinline__ float sigmoidf_(float x) { return 1.0f / (1.0f + __expf(-x)); }
__device__ __forceinline__ float siluf_(float x) { return x / (1.0f + __expf(-x)); }
__device__ __forceinline__ float logsigmoidf_(float x) { return fminf(x, 0.f) - __logf(1.0f + __expf(-fabsf(x))); }
template <int M> __device__ __forceinline__ float shx(float v) {
    static_assert(M < 32, "use xsum32");
    return __int_as_float(__builtin_amdgcn_ds_swizzle(__float_as_int(v), 0x1f | (M << 10)));
}
__device__ __forceinline__ float xsum32(float v) { const auto r = __builtin_amdgcn_permlane32_swap(__float_as_uint(v), __float_as_uint(v), false, false); return __uint_as_float(r[0]) + __uint_as_float(r[1]); }
__device__ __forceinline__ float wave_sum(float v) { v += shx<1>(v); v += shx<2>(v); v += shx<4>(v); v += shx<8>(v); v += shx<16>(v); return xsum32(v); }
__device__ __forceinline__ int row_of(int b, int p) { return p < SEG0_LEN ? b * SEG0_LEN + p : SEG0_ROWS + b * SEG1_LEN + (p - SEG0_LEN); }
__device__ __forceinline__ void bp_of(int row, int& b, int& p) { if (row < SEG0_ROWS) { b = row / SEG0_LEN; p = row - b * SEG0_LEN; } else { const int r = row - SEG0_ROWS; b = r >> 10; p = SEG0_LEN + (r & 1023); } }
#define XB_TMO      128
#define XB_XCNT(j)  (256  + 64 * (j))
#define XB_XSUB(j)  (1280 + 64 * (j))
#define XB_XGEN(j)  (2304 + 64 * (j))
#define XB_TOP      3328
#define XB_TOPGEN   3392
#define XCD_BAR_WORDS 3456
#define XB_SPIN_CAP (1u << 18)
#define LAS __attribute__((address_space(3)))

__device__ __forceinline__ unsigned xb_ld(unsigned* p)              { return __hip_atomic_load(p, __ATOMIC_RELAXED, __HIP_MEMORY_SCOPE_AGENT); }
__device__ __forceinline__ unsigned xb_add(unsigned* p, unsigned v) { return __hip_atomic_fetch_add(p, v, __ATOMIC_RELAXED, __HIP_MEMORY_SCOPE_AGENT); }
__device__ __forceinline__ unsigned xb_xcc_id() { return (unsigned)__builtin_amdgcn_s_getreg((3 << 11) | 20) & 0xFu; }
#define XB_SPIN(cond, bar) do { unsigned _sp = 0; while (cond) { __builtin_amdgcn_s_sleep(1); \
    if ((++_sp & 255u) == 0u) { if (xb_ld(&(bar)[XB_TMO])) break; if (_sp > XB_SPIN_CAP) { atomicAdd(&(bar)[XB_TMO], 1u); break; } } } } while (0)

struct XcdBarrier {
    unsigned* bar; unsigned x;
    volatile LAS unsigned* st;
};

__device__ __forceinline__ XcdBarrier xcd_barrier_post(unsigned* bar, volatile LAS unsigned* st) {
    XcdBarrier b; b.bar = bar; b.x = xb_xcc_id(); b.st = st;
    if (threadIdx.x == 0) (void)xb_add(&bar[XB_XCNT(b.x)], 1u);
    return b;
}
__device__ __forceinline__ void xcd_barrier_complete(unsigned* bar, unsigned x, unsigned& nloc, unsigned& nx) {
    const unsigned G = gridDim.x * gridDim.y * gridDim.z;
    unsigned sum, cnt, mine, sp = 0u;
    for (;;) {
        sum = 0u; cnt = 0u; mine = 0u;
#pragma unroll
        for (unsigned j = 0; j < 16; ++j) { const unsigned c = xb_ld(&bar[XB_XCNT(j)]); sum += c; cnt += (c > 0u) ? 1u : 0u; mine = (j == x) ? c : mine; }
        if (sum == G) break;
        __builtin_amdgcn_s_sleep(1);
        if ((++sp & 255u) == 0u) { if (xb_ld(&bar[XB_TMO])) break; if (sp > XB_SPIN_CAP) { atomicAdd(&bar[XB_TMO], 1u); break; } }
    }
    nloc = mine > 0u ? mine : 1u; nx = cnt > 0u ? cnt : 1u;
}

__device__ __forceinline__ void xcd_barrier(const XcdBarrier& b) {
    asm volatile("s_waitcnt vmcnt(0)" ::: "memory");
    __syncthreads();
    if (threadIdx.x == 0) {
        unsigned* bar = b.bar;
        __builtin_amdgcn_s_waitcnt(0);
        unsigned nloc = b.st[0], nx = b.st[1];
        if (nloc == 0u) { xcd_barrier_complete(bar, b.x, nloc, nx); b.st[0] = nloc; b.st[1] = nx; }
        const unsigned old = xb_add(&bar[XB_XSUB(b.x)], 1u);
        const unsigned gen = old / nloc;
        if (old + 1u == (gen + 1u) * nloc) {
            __builtin_amdgcn_fence(__ATOMIC_RELEASE, "agent");
            asm volatile("s_waitcnt vmcnt(0)" ::: "memory");
            const unsigned og = xb_add(&bar[XB_TOP], 1u);
            const unsigned tg = og / nx;
            if (og + 1u == (tg + 1u) * nx) xb_add(&bar[XB_TOPGEN], 1u);
            else XB_SPIN(xb_ld(&bar[XB_TOPGEN]) == tg, bar);
            __builtin_amdgcn_fence(__ATOMIC_ACQUIRE, "agent");
            xb_add(&bar[XB_XGEN(b.x)], 1u);
            asm volatile("s_waitcnt vmcnt(0)" ::: "memory");
        } else {
            XB_SPIN(xb_ld(&bar[XB_XGEN(b.x)]) == gen, bar);
            __builtin_amdgcn_fence(__ATOMIC_ACQUIRE, "agent");
            asm volatile("s_waitcnt vmcnt(0)" ::: "memory");
        }
    }
    __syncthreads();
}
#define DPP_ADD(v, ctrl) ((v) + __int_as_float(__builtin_amdgcn_update_dpp(0, __float_as_int(v), (ctrl), 0xf, 0xf, true)))
__device__ __forceinline__ float row16_sum(float v) { v = DPP_ADD(v, 0xB1); v = DPP_ADD(v, 0x4E); v = DPP_ADD(v, 0x141); v = DPP_ADD(v, 0x140); return v; }
struct Ctx {
    float* out; unsigned char* ws;
    LAS unsigned char* lds; int tid, lane, wave, G, wg;
    unsigned* ctl; float* H; bf16_t* HB; float* SS; bf16_t* Z;
};
__device__ __forceinline__ const float* inp(const Ctx& c, int k) {
    const LAS unsigned* t = (const LAS unsigned*)(c.lds + MISC_OFF + 64) + 2 * k;
    const unsigned lo = __builtin_amdgcn_readfirstlane(t[0]), hi = __builtin_amdgcn_readfirstlane(t[1]);
    return (const float*)(((unsigned long long)hi << 32) | lo);
}
struct LayerW {
    const bf16_t *Bin, *Bgrp, *Bbrg, *Bbrp, *Bout, *Bgu, *Bdn;
    const float *b_gate, *gla_nw, *pool_scale, *norm2_w, *w_rg, *w_re;
};
__device__ __forceinline__ LayerW layer_w(const Ctx& c, int l) {
    LayerW w; const unsigned char* base = (l == 0) ? (c.ws + WS_W0) : (const unsigned char*)c.out;
    w.Bin = (const bf16_t*)(base + W_IN); w.Bgrp = (const bf16_t*)(base + W_GRP); w.Bbrg = (const bf16_t*)(base + W_BRG); w.Bbrp = (const bf16_t*)(base + W_BRP);
    w.Bout = (const bf16_t*)(base + W_OUT); w.Bgu = (const bf16_t*)(base + W_GU); w.Bdn = (const bf16_t*)(base + W_DN);
    w.b_gate = inp(c, 5) + l * 512; w.gla_nw = inp(c, 6) + l * 256; w.pool_scale = inp(c, 8) + l * 1024; w.norm2_w = inp(c, 12) + l * 1024;
    w.w_rg = inp(c, 13) + (size_t)l * 1024 * 4; w.w_re = inp(c, 14) + (size_t)l * 1024 * 16;
    return w;
}

__device__ __forceinline__ float ss_row(const float* SS, int row) { const f32x4* p = (const f32x4*)(SS + (size_t)row * 16); const f32x4 a = p[0], b = p[1], c2 = p[2], d = p[3];
    return (((a[0] + a[1]) + (a[2] + a[3])) + ((b[0] + b[1]) + (b[2] + b[3]))) + (((c2[0] + c2[1]) + (c2[2] + c2[3])) + ((d[0] + d[1]) + (d[2] + d[3]))); }
template <int NS>
__device__ __forceinline__ void sg_acc_n(f32x4 (&acc)[4], const bf16_t* arow, const bf16_t* B, int ldb, int brow0, int lane) {
    const bf16_t* ap = arow + 8 * (lane >> 4);
    const bf16_t* bp = B + (size_t)(brow0 + (lane & 15)) * ldb + 8 * (lane >> 4);
    bf16x8 a[NS], b[NS][4];
#pragma unroll
    for (int s = 0; s < NS; ++s) { a[s] = *(const bf16x8*)(ap + 32 * s);
#pragma unroll
        for (int j = 0; j < 4; ++j) b[s][j] = *(const bf16x8*)(bp + (size_t)(16 * j) * ldb + 32 * s); }
#pragma unroll
    for (int s = 0; s < NS; ++s)
#pragma unroll
        for (int j = 0; j < 4; ++j) acc[j] = __builtin_amdgcn_mfma_f32_16x16x32_bf16(a[s], b[s][j], acc[j], 0, 0, 0);
}
#define ZERO_ACC(acc) do { _Pragma("unroll") for (int _j = 0; _j < 4; ++_j) acc[_j] = (f32x4){0.f, 0.f, 0.f, 0.f}; } while (0)
struct CvtItem { const float* src; int ldS, k0, n0; bf16_t* dst; int ldD, drow0; const float* rs; float cs; };
constexpr int CVT_A = 80 * 4, CVT_B = 0, CVT_C = 3 * 16 * 4, CVT_D = 16 * 16 * 4, CVT_E = 16 * 16 * 2, CVT_PER_LAYER = CVT_A + CVT_B + CVT_C + CVT_D + CVT_E;
__device__ __forceinline__ void cvt_decode(const Ctx& c, int l, int idx, CvtItem& it) {
    const uintptr_t i9 = (uintptr_t)inp(c, 9), i10 = (uintptr_t)inp(c, 10), i11 = (uintptr_t)inp(c, 11), i15 = (uintptr_t)inp(c, 15), i16 = (uintptr_t)inp(c, 16);
    unsigned char* base = (l == 0) ? (c.ws + WS_W0) : (unsigned char*)c.out;
    it.rs = nullptr; it.cs = 1.0f;
    if (idx < CVT_A) { const int nb = idx >> 2, kb = idx & 3;
        it.src = inp(c, 3) + (size_t)l * DM * IN_COLS; it.ldS = IN_COLS; it.k0 = kb * 256; it.dst = (bf16_t*)(base + W_IN); it.ldD = DM; it.rs = inp(c, 2) + l * DM;
        if (nb < 48) { it.n0 = nb * 64; it.drow0 = nb * 64; if (nb < 8) it.cs = 0.08838834764831845f; }
        else { it.n0 = 4112 + (nb - 48) * 64; it.drow0 = ZG0 + (nb - 48) * 64; }
        return; }
    idx -= CVT_A;
    if (idx < CVT_C) { const int m = idx >> 6, r = idx & 63, nb = r >> 2, kb = r & 3;
        it.src = (const float*)(m == 0 ? i9 : (m == 1 ? i10 : i11)) + (size_t)l * DM * DM; it.ldS = DM; it.k0 = kb * 256; it.n0 = nb * 64;
        it.dst = (bf16_t*)(base + (m == 0 ? W_BRG : (m == 1 ? W_BRP : W_OUT))); it.ldD = DM; it.drow0 = nb * 64; return; }
    idx -= CVT_C;
    if (idx < CVT_D) { const int e = idx >> 6, r = idx & 63, rb = r >> 2, kb = r & 3, j = rb >> 2, sub = rb & 3;
        const float* sp = (const float*)((sub < 2) ? i15 : i16);
        it.src = sp + ((size_t)l * 16 + e) * 1024 * 512; it.ldS = 512; it.k0 = kb * 256; it.n0 = 128 * j + 64 * (sub & 1);
        it.dst = (bf16_t*)(base + W_GU) + (size_t)e * 1024 * 1024; it.ldD = 1024; it.drow0 = rb * 64; it.rs = inp(c, 12) + l * DM; return; }
    idx -= CVT_D;
    { const int e = idx >> 5, r = idx & 31, nb = r >> 1, kb = r & 1;
        it.src = inp(c, 17) + ((size_t)l * 16 + e) * 512 * 1024; it.ldS = 1024; it.k0 = kb * 256; it.n0 = nb * 64;
        it.dst = (bf16_t*)(base + W_DN) + (size_t)e * 1024 * 512; it.ldD = 512; it.drow0 = nb * 64; }
}
__device__ __forceinline__ void phase_prep(const Ctx& c) {
    for (int row = c.wg * 8 + c.wave; row < T; row += c.G * 8) {
        int b, p; bp_of(row, b, p);
        const float* src = (p < NMETA) ? (inp(c, 1) + (size_t)p * DM) : (inp(c, 0) + ((size_t)b * SEQ + (p - NMETA)) * DM);
        float ss = 0.f;
#pragma unroll
        for (int i = 0; i < 4; ++i) { const int col = c.lane * 4 + 256 * i; const f32x4 v = *(const f32x4*)(src + col);
            ss += v[0] * v[0] + v[1] * v[1] + v[2] * v[2] + v[3] * v[3];
            u32x2 w; w.x = pk2(v[0], v[1]); w.y = pk2(v[2], v[3]); *(u32x2*)(c.HB + (size_t)row * DM + col) = w; }
        ss = wave_sum(ss);
        if (c.lane < 16) c.SS[(size_t)row * 16 + c.lane] = (c.lane == 0) ? ss : 0.f;
    }
    LAS float* tile = (LAS float*)c.lds;
    { float v[32]; CvtItem it; int idx = c.wg; bool have = idx < 2 * CVT_PER_LAYER;
      if (have) { const int l = idx / CVT_PER_LAYER; cvt_decode(c, l, idx - l * CVT_PER_LAYER, it);
#pragma unroll
          for (int i = 0; i < 32; ++i) { const int e = c.tid + 512 * i, kk = e >> 6, nn = e & 63; v[i] = it.src[(size_t)(it.k0 + kk) * it.ldS + it.n0 + nn]; } }
      while (have) {
        __syncthreads();
#pragma unroll
        for (int i = 0; i < 32; ++i) { const int e = c.tid + 512 * i, kk = e >> 6, nn = e & 63; float x = v[i] * it.cs; if (it.rs) x *= it.rs[it.k0 + kk]; tile[kk * 65 + nn] = x; }
        const CvtItem cur = it; idx += c.G; have = idx < 2 * CVT_PER_LAYER;
        if (have) { const int l = idx / CVT_PER_LAYER; cvt_decode(c, l, idx - l * CVT_PER_LAYER, it);
#pragma unroll
            for (int i = 0; i < 32; ++i) { const int e = c.tid + 512 * i, kk = e >> 6, nn = e & 63; v[i] = it.src[(size_t)(it.k0 + kk) * it.ldS + it.n0 + nn]; } }
        __syncthreads();
#pragma unroll
        for (int i = 0; i < 16; ++i) { const int e = c.tid + 512 * i, nn = e >> 7, kp = e & 127;
            *(unsigned*)(cur.dst + (size_t)(cur.drow0 + nn) * cur.ldD + cur.k0 + 2 * kp) = pk2(tile[(2 * kp) * 65 + nn], tile[(2 * kp + 1) * 65 + nn]); }
      } }
    __syncthreads();
    for (int idx = c.wg * 512 + c.tid; idx < 2 * 64 * 1024; idx += c.G * 512) {
        const int l = idx >> 16, jb = (idx >> 10) & 63, k = idx & 1023;
        const f32x4* wi4 = (const f32x4*)(inp(c, 3) + (size_t)l * DM * IN_COLS + (size_t)k * IN_COLS + 3072); const float* wu = inp(c, 4) + (size_t)l * 16 * 512 + 8 * jb;
        float wi[16];
#pragma unroll
        for (int q = 0; q < 4; ++q) { const f32x4 t4 = wi4[q]; wi[4 * q] = t4[0]; wi[4 * q + 1] = t4[1]; wi[4 * q + 2] = t4[2]; wi[4 * q + 3] = t4[3]; }
        float a[8];
#pragma unroll
        for (int j = 0; j < 8; ++j) a[j] = 0.f;
#pragma unroll
        for (int r = 0; r < 16; ++r) { const f32x4 u0 = *(const f32x4*)(wu + r * 512), u1 = *(const f32x4*)(wu + r * 512 + 4);
#pragma unroll
            for (int j = 0; j < 4; ++j) { a[j] += wi[r] * u0[j]; a[4 + j] += wi[r] * u1[j]; } }
        unsigned char* base = (l == 0) ? (c.ws + WS_W0) : (unsigned char*)c.out; const float nw = inp(c, 2)[l * DM + k];
#pragma unroll
        for (int j = 0; j < 8; ++j) ((bf16_t*)(base + W_IN))[(size_t)(ZG + 8 * jb + j) * DM + k] = f2bf(a[j] * nw);
    }
    for (int t = c.wg * 8 + c.wave; t < 2 * 64 * 16; t += c.G * 8) {
        const int l = t >> 10, k0 = ((t >> 4) & 63) * 16, n0 = (t & 15) * 64, g = n0 >> 8;
        const float* A = inp(c, 3) + (size_t)l * DM * IN_COLS + (size_t)(k0 + (c.lane & 15)) * IN_COLS + 3088 + 256 * g + (c.lane >> 4);
        const float* Bm = inp(c, 7) + (size_t)l * 4 * 65536 + (size_t)g * 65536 + (size_t)(c.lane >> 4) * 256 + (n0 & 255) + (c.lane & 15);
        f32x4 acc[4]; ZERO_ACC(acc);
#pragma unroll 4
        for (int c0 = 0; c0 < 256; c0 += 4) { const float a = A[c0];
#pragma unroll
            for (int j = 0; j < 4; ++j) acc[j] = __builtin_amdgcn_mfma_f32_16x16x4f32(a, Bm[(size_t)c0 * 256 + 16 * j], acc[j], 0, 0, 0); }
        unsigned char* base = (l == 0) ? (c.ws + WS_W0) : (unsigned char*)c.out; const float* nw = inp(c, 2) + l * DM + k0 + 4 * (c.lane >> 4); const float* sc = inp(c, 8) + l * 1024;
#pragma unroll
        for (int j = 0; j < 4; ++j) { const int n = n0 + 16 * j + (c.lane & 15); const float s = sc[n]; u32x2 pk; pk.x = pk2(acc[j][0] * nw[0] * s, acc[j][1] * nw[1] * s); pk.y = pk2(acc[j][2] * nw[2] * s, acc[j][3] * nw[3] * s);
            *(u32x2*)((bf16_t*)(base + W_IN) + (size_t)(ZU + n) * DM + k0 + 4 * (c.lane >> 4)) = pk; }
    }
}

__device__ __forceinline__ void sg_acc(f32x4 (&acc)[4], const bf16_t* arow, const bf16_t* B, int ldb, int brow0, int K, int lane) {
    const bf16_t* ap = arow + 8 * (lane >> 4);
    const bf16_t* bp = B + (size_t)(brow0 + (lane & 15)) * ldb + 8 * (lane >> 4);
    for (int k0 = 0; k0 < K; k0 += 32) {
        const bf16x8 a = *(const bf16x8*)(ap + k0);
#pragma unroll
        for (int j = 0; j < 4; ++j) { const bf16x8 b = *(const bf16x8*)(bp + (size_t)(16 * j) * ldb + k0); acc[j] = __builtin_amdgcn_mfma_f32_16x16x32_bf16(a, b, acc[j], 0, 0, 0); }
    }
}

__device__ __forceinline__ void pool_phase(const Ctx& c, int seg) {
    const int segbase = seg ? SEG0_ROWS : 0, segrows = seg ? SEG1_ROWS : SEG0_ROWS, seglen = seg ? SEG1_LEN : SEG0_LEN;
    bf16_t* halo = (bf16_t*)(c.ws + WS_HALO);
    const int RB = seg ? 16 : 20;
    const int nitem = (segrows / RB) * 128;
    for (int it = c.wg * 512 + c.tid; it < nitem; it += c.G * 512) {
        const int rb = it >> 7, cc = (it & 127) * 8, r0 = rb * RB, b = r0 / seglen, pl0 = r0 - b * seglen, p0 = seg ? SEG0_LEN + pl0 : pl0;
        const int w = 2 << (cc >> 8);
        float s[8];
#pragma unroll
        for (int j = 0; j < 8; ++j) s[j] = 0.f;
#define POOL_LD(dst, pl) do { const int pl_ = (pl); if (pl_ >= 0) dst = *(const u32x4*)(c.Z + (size_t)(b * seglen + pl_) * ZC + ZU + cc); else dst = *(const u32x4*)(halo + ((size_t)b * 15 + (15 + pl_)) * 1024 + cc); } while (0)
#define POOL_ACC(v, sgn) do { _Pragma("unroll") for (int j = 0; j < 4; ++j) { s[2 * j] += (sgn) * __uint_as_float((v)[j] << 16); s[2 * j + 1] += (sgn) * __uint_as_float((v)[j] & 0xffff0000u); } } while (0)
        { u32x4 hv[15];
#pragma unroll
          for (int i = 1; i < 16; ++i) { hv[i - 1] = (u32x4){0u, 0u, 0u, 0u}; if (i < w && p0 - i >= 0) POOL_LD(hv[i - 1], pl0 - i); }
#pragma unroll
          for (int i = 1; i < 16; ++i) POOL_ACC(hv[i - 1], 1.0f); }
        for (int rq = 0; rq < RB; rq += 4) {
            u32x4 cur[4], old[4];
#pragma unroll
            for (int q = 0; q < 4; ++q) { POOL_LD(cur[q], pl0 + rq + q); old[q] = (u32x4){0u, 0u, 0u, 0u}; if (p0 + rq + q - (w - 1) >= 0) POOL_LD(old[q], pl0 + rq + q - (w - 1)); }
#pragma unroll
            for (int q = 0; q < 4; ++q) { const int r = rq + q; POOL_ACC(cur[q], 1.0f);
                const int p = p0 + r, cnt = (p + 1 < w) ? p + 1 : w; const float inv = 1.0f / (float)cnt; u32x4 o;
#pragma unroll
                for (int j = 0; j < 4; ++j) o[j] = pk2(s[2 * j] * inv - __uint_as_float(cur[q][j] << 16), s[2 * j + 1] * inv - __uint_as_float(cur[q][j] & 0xffff0000u));
                *(u32x4*)(c.Z + (size_t)(r0 + r) * ZC + ZQ + cc) = o;
                if (seg == 0 && pl0 + r >= SEG0_LEN - 15) *(u32x4*)(halo + ((size_t)b * 15 + (pl0 + r - (SEG0_LEN - 15))) * 1024 + cc) = cur[q];
                POOL_ACC(old[q], -1.0f); }
        }
#undef POOL_LD
#undef POOL_ACC
    }
}
__device__ __forceinline__ void ygla_phase(const Ctx& c, const LayerW& w, int segrows) {
    const int col = c.lane * 16;
    float nwv[16];
    { const f32x4* np = (const f32x4*)(w.gla_nw + (col & 255));
#pragma unroll
      for (int q = 0; q < 4; ++q) { const f32x4 t4 = np[q]; nwv[4 * q] = t4[0]; nwv[4 * q + 1] = t4[1]; nwv[4 * q + 2] = t4[2]; nwv[4 * q + 3] = t4[3]; } }
    for (int r = (c.wg * 8 + c.wave) * 2; r < segrows; r += c.G * 16) {
        u32x4 ov[2][2], gv[2][2];
#pragma unroll
        for (int q = 0; q < 2; ++q) { const bf16_t* zr = c.Z + (size_t)(r + q) * ZC; ov[q][0] = *(const u32x4*)(zr + ZV + col); ov[q][1] = *(const u32x4*)(zr + ZV + col + 8); gv[q][0] = *(const u32x4*)(zr + ZOG + col); gv[q][1] = *(const u32x4*)(zr + ZOG + col + 8); }
#pragma unroll
        for (int q = 0; q < 2; ++q) {
            float o[16], sg[16];
#pragma unroll
            for (int j = 0; j < 4; ++j) { o[2 * j] = __uint_as_float(ov[q][0][j] << 16); o[2 * j + 1] = __uint_as_float(ov[q][0][j] & 0xffff0000u); o[8 + 2 * j] = __uint_as_float(ov[q][1][j] << 16); o[8 + 2 * j + 1] = __uint_as_float(ov[q][1][j] & 0xffff0000u);
                sg[2 * j] = __uint_as_float(gv[q][0][j] << 16); sg[2 * j + 1] = __uint_as_float(gv[q][0][j] & 0xffff0000u); sg[8 + 2 * j] = __uint_as_float(gv[q][1][j] << 16); sg[8 + 2 * j + 1] = __uint_as_float(gv[q][1][j] & 0xffff0000u); }
            float ss = 0.f;
#pragma unroll
            for (int j = 0; j < 16; ++j) ss += o[j] * o[j];
            ss = row16_sum(ss);
            const float rs = rsqrtf(ss * (1.0f / 256.0f) + EPS);
            u32x4 y0, y1;
#pragma unroll
            for (int j = 0; j < 4; ++j) { y0[j] = pk2(o[2 * j] * rs * nwv[2 * j] * sg[2 * j], o[2 * j + 1] * rs * nwv[2 * j + 1] * sg[2 * j + 1]);
                y1[j] = pk2(o[8 + 2 * j] * rs * nwv[8 + 2 * j] * sg[8 + 2 * j], o[8 + 2 * j + 1] * rs * nwv[8 + 2 * j + 1] * sg[8 + 2 * j + 1]); }
            bf16_t* zr = c.Z + (size_t)(r + q) * ZC; *(u32x4*)(zr + ZOG + col) = y0; *(u32x4*)(zr + ZOG + col + 8) = y1; }
    }
}
__device__ __forceinline__ void route_phase(const Ctx& c, const LayerW& w, int layer) {
    constexpr int WST = 2064;
    LAS unsigned char* WH = c.lds; LAS unsigned char* WM = c.lds + 20 * WST;
    LAS float* LG = (LAS float*)(c.lds + 40 * WST);
    LAS unsigned* lcnt = (LAS unsigned*)(c.lds + 93184);
    LAS int* rinfo = (LAS int*)(c.lds + 93184 + 256);
    { f32x4 rg[2], re[2][4]; float nw[2];
#pragma unroll
      for (int q = 0; q < 2; ++q) { const int k = c.tid + 512 * q; rg[q] = *(const f32x4*)(w.w_rg + k * 4); nw[q] = w.norm2_w[k];
#pragma unroll
          for (int u = 0; u < 4; ++u) re[q][u] = *(const f32x4*)(w.w_re + k * 16 + 4 * u); }
#pragma unroll
      for (int q = 0; q < 2; ++q) { const int k = c.tid + 512 * q;
#pragma unroll
          for (int j = 0; j < 20; ++j) { const float v = ((j < 4) ? rg[q][j & 3] : re[q][(j - 4) >> 2][(j - 4) & 3]) * nw[q]; const bf16_t hi = f2bf(v); const bf16_t mid = f2bf(v - bf2f(hi));
              *(LAS bf16_t*)(WH + j * WST + 2 * k) = hi; *(LAS bf16_t*)(WM + j * WST + 2 * k) = mid; } } }
    if (c.tid < 64) lcnt[c.tid] = 0u;
    __syncthreads();
    int* LIST = (int*)((unsigned char*)c.Z + MZ_LIST); float* WTS = (float*)((unsigned char*)c.Z + MZ_WTS);
    unsigned* cnt = c.ctl + CW_CNT + layer * 2048;
    const int fr = c.lane & 15, g = c.lane >> 4;
    const int bn0 = fr, bn1 = (16 + fr < 20) ? 16 + fr : 19;
    constexpr int ntmax = 4;
    int nloc = 0;
    for (int tile = c.wg * 8 + c.wave; tile < T / 16; tile += c.G * 8, ++nloc) {
        const float* hr = c.H + (size_t)(tile * 16 + fr) * DM + 8 * g;
        f32x4 a0 = (f32x4){0.f, 0.f, 0.f, 0.f}, a1 = a0; float ss = 0.f;
#pragma unroll 4
        for (int s = 0; s < 32; ++s) {
            const f32x4 x0 = *(const f32x4*)(hr + 32 * s), x1 = *(const f32x4*)(hr + 32 * s + 4);
            ss += (x0[0] * x0[0] + x0[1] * x0[1]) + (x0[2] * x0[2] + x0[3] * x0[3]) + (x1[0] * x1[0] + x1[1] * x1[1]) + (x1[2] * x1[2] + x1[3] * x1[3]);
            const u32x4 hw = (u32x4){pk2(x0[0], x0[1]), pk2(x0[2], x0[3]), pk2(x1[0], x1[1]), pk2(x1[2], x1[3])};
            const u32x4 mw = (u32x4){pk2(x0[0] - bflo(hw[0]), x0[1] - bfhi(hw[0])), pk2(x0[2] - bflo(hw[1]), x0[3] - bfhi(hw[1])), pk2(x1[0] - bflo(hw[2]), x1[1] - bfhi(hw[2])), pk2(x1[2] - bflo(hw[3]), x1[3] - bfhi(hw[3]))};
            bf16x8 ah, am; __builtin_memcpy(&ah, &hw, 16); __builtin_memcpy(&am, &mw, 16);
            const int ko = (32 * s + 8 * g) * 2;
            const bf16x8 bh0 = *(const LAS bf16x8*)(WH + bn0 * WST + ko), bm0 = *(const LAS bf16x8*)(WM + bn0 * WST + ko), bh1 = *(const LAS bf16x8*)(WH + bn1 * WST + ko), bm1 = *(const LAS bf16x8*)(WM + bn1 * WST + ko);
            a0 = __builtin_amdgcn_mfma_f32_16x16x32_bf16(am, bh0, a0, 0, 0, 0); a0 = __builtin_amdgcn_mfma_f32_16x16x32_bf16(ah, bm0, a0, 0, 0, 0); a0 = __builtin_amdgcn_mfma_f32_16x16x32_bf16(ah, bh0, a0, 0, 0, 0);
            a1 = __builtin_amdgcn_mfma_f32_16x16x32_bf16(am, bh1, a1, 0, 0, 0); a1 = __builtin_amdgcn_mfma_f32_16x16x32_bf16(ah, bm1, a1, 0, 0, 0); a1 = __builtin_amdgcn_mfma_f32_16x16x32_bf16(ah, bh1, a1, 0, 0, 0);
        }
        ss += shx<16>(ss); ss = xsum32(ss);
        const float rstd = rsqrtf(ss * (1.0f / DM) + EPS);
        LAS float* lgw = LG + c.wave * 320;
#pragma unroll
        for (int r = 0; r < 4; ++r) { lgw[(4 * g + r) * 20 + fr] = a0[r]; if (fr < 4) lgw[(4 * g + r) * 20 + 16 + fr] = a1[r]; }
        asm volatile("s_waitcnt lgkmcnt(0)" ::: "memory");
        if (g == 0) {
            float lg[20];
#pragma unroll
            for (int j = 0; j < 5; ++j) { const f32x4 v = *(const LAS f32x4*)(lgw + fr * 20 + 4 * j); lg[4 * j] = v[0] * rstd; lg[4 * j + 1] = v[1] * rstd; lg[4 * j + 2] = v[2] * rstd; lg[4 * j + 3] = v[3] * rstd; }
            int gi = 0; float gm = lg[0];
#pragma unroll
            for (int j = 1; j < 4; ++j) if (lg[j] > gm) { gm = lg[j]; gi = j; }
            float den = 0.f;
#pragma unroll
            for (int j = 0; j < 4; ++j) den += __expf(lg[j] - gm);
            const float pg = 1.0f / den;
            float le[4];
#pragma unroll
            for (int j = 0; j < 4; ++j) le[j] = (gi == 0) ? +lg[4 + j] : (gi == 1) ? +lg[8 + j] : (gi == 2) ? +lg[12 + j] : +lg[16 + j];
            int i1 = 0; float m1 = le[0];
#pragma unroll
            for (int j = 1; j < 4; ++j) if (le[j] > m1) { m1 = le[j]; i1 = j; }
            int i2 = -1; float m2 = -3.0e38f;
#pragma unroll
            for (int j = 0; j < 4; ++j) if (j != i1 && le[j] > m2) { m2 = le[j]; i2 = j; }
            const float w1 = pg / (1.0f + __expf(m2 - m1)), w2 = pg - w1;
            const int a = i1 < i2 ? +i1 : +i2, bq = i1 < i2 ? +i2 : +i1; const float wa = i1 < i2 ? +w1 : +w2, wb = i1 < i2 ? +w2 : +w1;
            const int pidx = (a == 0) ? (bq - 1) : (a == 1) ? (bq + 1) : 5;
            const int cls = gi * 6 + pidx;
            const unsigned lslot = __hip_atomic_fetch_add(lcnt + cls, 1u, __ATOMIC_RELAXED, __HIP_MEMORY_SCOPE_WORKGROUP);
            LAS int* ri = rinfo + ((c.wave * ntmax + nloc) * 16 + fr) * 8;
            ri[0] = tile * 16 + fr; ri[1] = (cls << 16) | (int)lslot; ri[2] = __float_as_int(wa); ri[3] = __float_as_int(wb); ri[4] = __float_as_int(rstd);
        }
    }
    __syncthreads();
    if (c.tid < NCLS) { const unsigned n = lcnt[c.tid]; lcnt[32 + c.tid] = n ? atomicAdd(cnt + 64 * c.tid, n) : 0u; }
    __syncthreads();
    for (int e = c.tid; e < 8 * ntmax * 16; e += 512) { const int wv = e / (ntmax * 16), nl = (e / 16) % ntmax;
        int nmine = 0; for (int t0 = c.wg * 8 + wv; t0 < T / 16; t0 += c.G * 8) ++nmine;
        if (nl < nmine) { const LAS int* ri = rinfo + e * 8; const int row = ri[0], cls = ri[1] >> 16, ls = ri[1] & 0xffff;
            const size_t slot = (size_t)cls * T + lcnt[32 + cls] + ls; LIST[slot] = row; *(f32x4*)(WTS + slot * 4) = (f32x4){__int_as_float(ri[2]), __int_as_float(ri[3]), __int_as_float(ri[4]), 0.f}; } }
}
struct MoeTab { LAS int* cls; LAS int* til; LAS int* cntv; int ntiles; };
__device__ __forceinline__ MoeTab moe_table(const Ctx& c, int layer) {
    MoeTab mt; mt.cls = (LAS int*)(c.lds + MISC_OFF - 4096); mt.til = mt.cls + MAXCT; mt.cntv = mt.til + MAXCT;
    __syncthreads();
    if (c.tid == 0) { const unsigned* cnt = c.ctl + CW_CNT + layer * 2048; int n = 0;
#pragma unroll 1
        for (int k = 0; k < NCLS; ++k) { const int cv = (int)__hip_atomic_load(cnt + 64 * k, __ATOMIC_RELAXED, __HIP_MEMORY_SCOPE_AGENT); mt.cntv[k] = cv; const int nt = (cv + 255) >> 8;
#pragma unroll 1
            for (int t = 0; t < nt && n < MAXCT; ++t) { mt.cls[n] = k; mt.til[n] = t; ++n; } }
        mt.cntv[NCLS] = n; }
    __syncthreads();
    mt.ntiles = __builtin_amdgcn_readfirstlane(mt.cntv[NCLS]);
    return mt;
}
__device__ __forceinline__ void cls_experts(int cls, int& ea, int& eb) { const int g = cls / 6, pi = cls - g * 6; const int a = pi < 3 ? 0 : (pi < 5 ? 1 : 2); const int b = pi < 3 ? pi + 1 : (pi < 5 ? pi - 1 : 3); ea = g * 4 + a; eb = g * 4 + b; }
__device__ __forceinline__ void final_phase(const Ctx& c) {
    const float* fw = inp(c, 18);
    for (int o = c.wg * 8 + c.wave; o < NB * SEQ; o += c.G * 8) {
        const int b = o >> 11, sidx = o & 2047, row = row_of(b, sidx + NMETA);
        const float rstd = rsqrtf(ss_row(c.SS, row) * (1.0f / DM) + EPS);
#pragma unroll
        for (int i = 0; i < 4; ++i) { const int col = c.lane * 4 + 256 * i; const f32x4 v = *(const f32x4*)(c.H + (size_t)row * DM + col), wv = *(const f32x4*)(fw + col);
            *(f32x4*)(c.out + (size_t)o * DM + col) = v * rstd * wv; }
    }
}
namespace og {
constexpr int BM = 256, BK = 64, HALF = 128, HTB = HALF * BK * 2, STAGE_BYTES = 8 * HTB;
__device__ __forceinline__ int lds_byte(int r, int c) { const int st = (r >> 4) * 2 + (c >> 5), rr = r & 15, cc = c & 31, ob = rr * 64 + cc * 2; return st * 1024 + (ob ^ (((ob >> 9) & 1) << 5)); }
__device__ __forceinline__ void stage_rc(int b, int& R, int& C) { const int st = b / 1024, sb = b % 1024, swz = sb ^ (((sb >> 9) & 1) << 5); R = (st >> 1) * 16 + swz / 64; C = (st & 1) * 32 + (swz % 64) / 2; }
__device__ __forceinline__ int perm32(int rho) { const int n = rho >> 4, i = rho & 15; return 8 * (i >> 2) + 4 * n + (i & 3); }
__device__ __forceinline__ unsigned cvt_pk_bf16(float lo, float hi) { unsigned r; asm volatile("v_cvt_pk_bf16_f32 %0, %1, %2" : "=v"(r) : "v"(lo), "v"(hi)); return r; }

struct UD { const char* A; const char* B; const int* gl; int gvalid; int mid; int p0, p1, p2, p3; };

typedef f32x4 Acc[2][2][4][2];

template <class Epi, class Sched, bool GATHER>
__device__ __forceinline__ void gemm_run(LAS unsigned char* lds, const Sched& S, const Epi& E, const unsigned lda, const unsigned ldb, const int nt) {
    int tid = threadIdx.x; asm volatile("" : "+v"(tid));
    const int wid = __builtin_amdgcn_readfirstlane(tid >> 6), lane = tid & 63, wr = wid >> 2, wc = wid & 3, fr = lane & 15, fq = lane >> 4;
    unsigned voffB[2];
#pragma unroll
    for (int i = 0; i < 2; ++i) { int R, C; stage_rc(tid * 16 + i * 8192, R, C); const int Rb = (R & ~31) + perm32(R & 31); voffB[i] = (unsigned)Rb * ldb + (unsigned)C * 2u; }
    const size_t kstep = (size_t)(BK * 2);
    const size_t hstepB = (size_t)HALF * ldb;
    const size_t hstepA = GATHER ? (size_t)0 : (size_t)HALF * lda;
    const unsigned ldsw = (unsigned)wid * 1024u;
    const int aoff = lds_byte(wr * 64 + fr, fq * 8), boff = lds_byte(wc * 32 + fr, fq * 8);
#define OG_SA(b, h) (((b) * 2 + (h)) * HTB)
#define OG_SB(b, h) ((4 + (b) * 2 + (h)) * HTB)
#define OG_STAGE(bufoff, gbase, voff) do { _Pragma("unroll") for (int _i = 0; _i < 2; ++_i) \
        __builtin_amdgcn_global_load_lds((const unsigned*)((const char*)(gbase) + (voff)[_i]), (LAS unsigned*)(lds + (bufoff) + ldsw + _i * 8192), 16, 0, 0); } while (0)
#define OG_LDA(dst, b, h) do { _Pragma("unroll") for (int m = 0; m < 4; ++m) _Pragma("unroll") for (int k = 0; k < 2; ++k) dst[m][k] = *(const LAS bf16x8*)(lds + OG_SA(b, h) + aoff + m * 2048 + k * 1024); } while (0)
#define OG_LDB(dst, b, h) do { _Pragma("unroll") for (int n = 0; n < 2; ++n) _Pragma("unroll") for (int k = 0; k < 2; ++k) dst[n][k] = *(const LAS bf16x8*)(lds + OG_SB(b, h) + boff + n * 2048 + k * 1024); } while (0)
#define OG_MMA(ai, bj, At, Bt) do { __builtin_amdgcn_s_setprio(1); _Pragma("unroll") for (int m = 0; m < 4; ++m) _Pragma("unroll") for (int n = 0; n < 2; ++n) _Pragma("unroll") for (int k = 0; k < 2; ++k) \
        acc[ai][bj][m][n] = __builtin_amdgcn_mfma_f32_16x16x32_bf16(Bt[n][k], At[m][k], acc[ai][bj][m][n], 0, 0, 0); __builtin_amdgcn_s_setprio(0); } while (0)
#define OG_WAIT_V(n) asm volatile("s_waitcnt vmcnt(" #n ")" ::: "memory")
#define OG_WAIT_L(n) asm volatile("s_waitcnt lgkmcnt(" #n ")" ::: "memory")
#define OG_BAR __builtin_amdgcn_s_barrier()
#define OG_SCHED __builtin_amdgcn_sched_barrier(0)
#define OG_SETOFF(dst, u) do { int _t = threadIdx.x; asm volatile("" : "+v"(_t)); _Pragma("unroll") for (int _i = 0; _i < 2; ++_i) { int _R, _C; stage_rc(_t * 16 + _i * 8192, _R, _C); \
        _Pragma("unroll") for (int _h = 0; _h < 2; ++_h) { const int _r = _h * HALF + _R; \
        int _row = _r; if (GATHER) _row = (u).gl[_r < (u).gvalid ? _r : 0]; dst[_h][_i] = (unsigned)_row * lda + (unsigned)_C * 2u; } } } while (0)
    UD cur, nxt; int ui = 0;
    if (!S.get(0, cur)) return;
    Acc acc;
    { float z0 = 0.f; asm volatile("" : "+v"(z0));
#pragma unroll
    for (int a = 0; a < 2; ++a)
#pragma unroll
        for (int b = 0; b < 2; ++b)
#pragma unroll
            for (int m = 0; m < 4; ++m)
#pragma unroll
                for (int n = 0; n < 2; ++n) acc[a][b][m][n] = (f32x4){z0, z0, z0, z0}; }
    bf16x8 At[4][2], B0[2][2], B1[2][2];
    unsigned oA[2][2], oN[2][2];
    OG_SETOFF(oA, cur);
    const char* cA = cur.A; const char* cB = cur.B;
    OG_STAGE(OG_SB(0, 0), cB, voffB); OG_STAGE(OG_SB(0, 1), cB + hstepB, voffB); OG_STAGE(OG_SA(0, 0), cA, oA[0]); OG_STAGE(OG_SA(0, 1), cA + hstepA, oA[GATHER ? 1 : 0]);
    if (wr == 1) OG_BAR;
    OG_WAIT_V(2); OG_BAR;
    OG_STAGE(OG_SB(1, 0), cB + kstep, voffB); OG_STAGE(OG_SA(1, 0), cA + kstep, oA[0]); OG_STAGE(OG_SB(1, 1), cB + hstepB + kstep, voffB);
    OG_WAIT_V(6); OG_BAR;
    for (;;) {
        const bool has_next = S.get(ui + 1, nxt);
        const char* nA = has_next ? nxt.A : cA; const char* nB = has_next ? nxt.B : cB;
        if (GATHER) { if (has_next) { OG_SETOFF(oN, nxt); } else {
#pragma unroll
            for (int h = 0; h < 2; ++h)
#pragma unroll
                for (int i = 0; i < 2; ++i) oN[h][i] = oA[h][i]; } }
#pragma unroll 1
        for (int t = 0; t < nt; t += 2) {
            const bool last = (t == nt - 2);
            const char* a1 = cA + (size_t)(t + 1) * kstep;
            const char* a2 = last ? nA : cA + (size_t)(t + 2) * kstep; const char* b2 = last ? nB : cB + (size_t)(t + 2) * kstep;
            const char* a3 = a2 + kstep; const char* b3 = b2 + kstep;
            unsigned o2[2][2];
#pragma unroll
            for (int h = 0; h < 2; ++h)
#pragma unroll
                for (int i = 0; i < 2; ++i) o2[h][i] = (GATHER && last) ? oN[h][i] : oA[h][i];
            OG_LDB(B0, 0, 0); OG_LDB(B1, 0, 1); OG_SCHED; OG_LDA(At, 0, 0); OG_STAGE(OG_SA(1, 1), a1 + hstepA, oA[GATHER ? 1 : 0]);
            OG_WAIT_V(8); OG_WAIT_L(0); OG_BAR; OG_MMA(0, 0, At, B0); OG_MMA(0, 1, At, B1); OG_BAR; OG_SCHED;
            OG_LDA(At, 0, 1); OG_STAGE(OG_SB(0, 0), b2, voffB); OG_STAGE(OG_SB(0, 1), b2 + hstepB, voffB); OG_STAGE(OG_SA(0, 0), a2, o2[0]);
            OG_WAIT_V(8); OG_WAIT_L(0); OG_BAR; OG_MMA(1, 0, At, B0); OG_MMA(1, 1, At, B1); OG_BAR; OG_SCHED;
            OG_LDB(B0, 1, 0); OG_LDB(B1, 1, 1); OG_SCHED; OG_LDA(At, 1, 0); OG_STAGE(OG_SA(0, 1), a2 + hstepA, o2[GATHER ? 1 : 0]);
            OG_WAIT_V(8); OG_WAIT_L(0); OG_BAR; OG_MMA(0, 0, At, B0); OG_MMA(0, 1, At, B1); OG_BAR; OG_SCHED;
            OG_LDA(At, 1, 1); OG_STAGE(OG_SB(1, 0), b3, voffB); OG_STAGE(OG_SB(1, 1), b3 + hstepB, voffB); OG_STAGE(OG_SA(1, 0), a3, o2[0]);
            OG_WAIT_V(8); OG_WAIT_L(0); OG_BAR; OG_MMA(1, 0, At, B0); OG_MMA(1, 1, At, B1); OG_BAR; OG_SCHED;
        }
        const bool ep_now = !(Epi::MID_EMPTY && cur.mid);
        if (ep_now && wr == 0) OG_BAR;
#ifdef PROBE_EPI
        unsigned long long pe_t0 = 0ull; if (blockIdx.x == 0) pe_t0 = wall_clock64();
#endif
        { int t2 = threadIdx.x; asm volatile("" : "+v"(t2));
          const int w2 = __builtin_amdgcn_readfirstlane(t2 >> 6), wr2 = w2 >> 2, wc2 = w2 & 3, fr2 = t2 & 15, fq2 = (t2 >> 4) & 3;
          if constexpr (Epi::UNIFIED) { E.uni(acc, cur, wr2, wc2, fr2, fq2); }
          else { if (cur.mid) { E.mid(acc, cur, wr2, wc2, fr2, fq2); } else { E(acc, cur, wr2, wc2, fr2, fq2); } } }
#ifdef PROBE_EPI
        if (blockIdx.x == 0 && threadIdx.x == 0) { volatile LAS unsigned long long* pa = (volatile LAS unsigned long long*)(lds + MISC_OFF + 32); if (pa[1] != 0ull) { asm volatile("s_waitcnt vmcnt(0)" ::: "memory"); pa[0] += wall_clock64() - pe_t0; } }
#endif
        if (!has_next) break;
        if (!cur.mid) { float z0 = 0.f; asm volatile("" : "+v"(z0));
#pragma unroll
            for (int a = 0; a < 2; ++a)
#pragma unroll
                for (int b = 0; b < 2; ++b)
#pragma unroll
                    for (int m = 0; m < 4; ++m)
#pragma unroll
                        for (int n = 0; n < 2; ++n) acc[a][b][m][n] = (f32x4){z0, z0, z0, z0};
        }
        cur = nxt; cA = nA; cB = nB; ++ui;
        if (GATHER) {
#pragma unroll
            for (int h = 0; h < 2; ++h)
#pragma unroll
                for (int i = 0; i < 2; ++i) oA[h][i] = oN[h][i]; }
        if (ep_now && wr == 1) OG_BAR;
    }
    OG_WAIT_V(0);
    OG_BAR;
#undef OG_SA
#undef OG_SB
#undef OG_STAGE
#undef OG_LDA
#undef OG_LDB
#undef OG_MMA
#undef OG_WAIT_V
#undef OG_WAIT_L
#undef OG_BAR
#undef OG_SCHED
#undef OG_SETOFF
}

__device__ __forceinline__ void grid_tile(int L, int nM, int nN, int& pm, int& pn) {
    const int nwg = nM * nN; int wgid = L; { const int q = nwg / 8, r = nwg % 8, xcd = wgid % 8, off = wgid / 8; wgid = (xcd < r ? xcd * (q + 1) : r * (q + 1) + (xcd - r) * q) + off; }
    const int nig = 8 * nN, gid = wgid / nig, fm = gid * 8, gsz = (nM - fm) < 8 ? (nM - fm) : 8;
    pm = fm + ((wgid % nig) % gsz); pn = (wgid % nig) / gsz;
}
#define OG_ROWS for (int ai = 0; ai < 2; ++ai) _Pragma("unroll") for (int m = 0; m < 4; ++m)
__device__ __forceinline__ int og_row(int cst, int base) { int v = cst; asm volatile("" : "+v"(v)); return v + base; }
#define OG_ROW og_row(ai * 128 + m * 16, wr * 64 + fr)
#define OG_COL(bj) ((bj) * 128 + wc * 32 + fq * 8)
__device__ __forceinline__ void unpack8(const u32x4 v, float (&f)[8]) {
#pragma unroll
    for (int j = 0; j < 4; ++j) { f[2 * j] = __uint_as_float(v[j] << 16); f[2 * j + 1] = __uint_as_float(v[j] & 0xffff0000u); } }
__device__ __forceinline__ u32x4 pack8(const f32x4 a, const f32x4 b) { u32x4 w; w.x = cvt_pk_bf16(a[0], a[1]); w.y = cvt_pk_bf16(a[2], a[3]); w.z = cvt_pk_bf16(b[0], b[1]); w.w = cvt_pk_bf16(b[2], b[3]); return w; }

struct SchedP1 { const char* A; const char* B; int nM, G, wg;
    __device__ __forceinline__ bool get(int i, UD& u) const { const int L = i * G + wg; if (L >= nM * 26) return false; int pm, pn; grid_tile(L, nM, 26, pm, pn);
        u.A = A + (size_t)pm * 256 * 2048; u.B = B + (size_t)pn * 256 * 2048; u.gl = nullptr; u.gvalid = 0; u.mid = 0; u.p0 = pm; u.p1 = pn; u.p2 = 0; u.p3 = 0; return true; } };
struct EpiP1 { static constexpr bool UNIFIED = false, MID_EMPTY = false; bf16_t* Z; const float* SS; const float* b_gate;
    __device__ __forceinline__ void mid(Acc&, const UD&, int, int, int, int) const {}
    __device__ __forceinline__ void operator()(const Acc& acc, const UD& u, int wr, int wc, int fr, int fq) const {
        const int pm = u.p0, pn = u.p1; const int kind = (pn < 8) ? 0 : (pn < 12) ? 1 : (pn < 14) ? 2 : (pn < 18) ? 0 : 3;
        float bg[2][8];
#pragma unroll
        for (int bj = 0; bj < 2; ++bj)
#pragma unroll
            for (int j = 0; j < 8; ++j) bg[bj][j] = 0.f;
        if (kind == 2) {
#pragma unroll
            for (int bj = 0; bj < 2; ++bj) { const float* bp = b_gate + (pn - 12) * 256 + OG_COL(bj); const f32x4 x0 = *(const f32x4*)bp, x1 = *(const f32x4*)(bp + 4);
#pragma unroll
                for (int j = 0; j < 4; ++j) { bg[bj][j] = x0[j]; bg[bj][4 + j] = x1[j]; } } }
#pragma unroll
        OG_ROWS { const int row = pm * 256 + OG_ROW;
            float ssum; { const f32x4 pv = *(const f32x4*)(SS + (size_t)row * 16 + 4 * fq); ssum = (pv[0] + pv[1]) + (pv[2] + pv[3]); ssum += shx<16>(ssum); ssum = xsum32(ssum); }
            const float rstd = rsqrtf(ssum * (1.0f / DM) + EPS);
#pragma unroll
            for (int bj = 0; bj < 2; ++bj) { f32x4 v0 = acc[ai][bj][m][0] * rstd, v1 = acc[ai][bj][m][1] * rstd;
                if (kind == 1) {
#pragma unroll
                    for (int j = 0; j < 4; ++j) { v0[j] = siluf_(v0[j]); v1[j] = siluf_(v1[j]); } }
                else if (kind == 2) {
#pragma unroll
                    for (int j = 0; j < 4; ++j) { v0[j] = logsigmoidf_(v0[j] + bg[bj][j]) * 0.0625f; v1[j] = logsigmoidf_(v1[j] + bg[bj][4 + j]) * 0.0625f; } }
                else if (kind == 3) {
#pragma unroll
                    for (int j = 0; j < 4; ++j) { v0[j] = sigmoidf_(v0[j]); v1[j] = sigmoidf_(v1[j]); } }
                *(u32x4*)(Z + (size_t)row * ZC + pn * 256 + OG_COL(bj)) = pack8(v0, v1); } }
    } };
struct SchedP4 { const char* Z; const char* Bg; const char* Bp; int nM, G, wg;
    __device__ __forceinline__ bool get(int i, UD& u) const { const int L = (i >> 1) * G + wg; if (L >= nM * 4) return false; int pm, pn; grid_tile(L, nM, 4, pm, pn); const int part = i & 1;
        u.A = Z + (size_t)pm * 256 * (ZC * 2) + (part ? ZQ * 2 : ZOG * 2); u.B = (part ? Bp : Bg) + (size_t)pn * 256 * 2048; u.gl = nullptr; u.gvalid = 0; u.mid = part ? 0 : 1; u.p0 = pm; u.p1 = pn; u.p2 = 0; u.p3 = 0; return true; } };
struct EpiP4 { static constexpr bool UNIFIED = true, MID_EMPTY = false; bf16_t* Z;
    __device__ __forceinline__ void uni(Acc& acc, const UD& u, int wr, int wc, int fr, int fq) const {
        const int pm = u.p0, pn = u.p1; const bool mid = u.mid != 0;
#pragma unroll
        for (int ai = 0; ai < 2; ++ai) {
            u32x4 gv0[4][2], gv1[4][2]; bf16_t* zp[4];
#pragma unroll
            for (int m = 0; m < 4; ++m) { const int row = pm * 256 + OG_ROW; zp[m] = Z + (size_t)row * ZC + pn * 256 + OG_COL(0);
#pragma unroll
                for (int bj = 0; bj < 2; ++bj) { gv1[m][bj] = *(const u32x4*)(zp[m] + bj * 128 + ZG1); gv0[m][bj] = mid ? *(const u32x4*)(zp[m] + bj * 128 + ZG0) : gv1[m][bj]; } }
#pragma unroll
            for (int m = 0; m < 4; ++m)
#pragma unroll
                for (int bj = 0; bj < 2; ++bj) { float g0[8], g1[8]; unpack8(gv0[m][bj], g0); unpack8(gv1[m][bj], g1); f32x4 v0, v1;
                    if (mid) {
#pragma unroll
                        for (int j = 0; j < 4; ++j) { v0[j] = acc[ai][bj][m][0][j] * (g0[j] * __builtin_amdgcn_rcpf(fmaxf(g1[j], 1e-30f))); v1[j] = acc[ai][bj][m][1][j] * (g0[4 + j] * __builtin_amdgcn_rcpf(fmaxf(g1[4 + j], 1e-30f))); }
                    } else {
#pragma unroll
                        for (int j = 0; j < 4; ++j) { v0[j] = acc[ai][bj][m][0][j] * fmaxf(g1[j], 1e-30f); v1[j] = acc[ai][bj][m][1][j] * fmaxf(g1[4 + j], 1e-30f); } }
                    acc[ai][bj][m][0] = v0; acc[ai][bj][m][1] = v1;
                    if (!mid) *(u32x4*)(zp[m] + bj * 128 + ZV) = pack8(v0, v1); }
            asm volatile("" ::: "memory"); }
    } };
struct SchedP5 { const char* Z; const char* B; int nM, G, wg;
    __device__ __forceinline__ bool get(int i, UD& u) const { const int L = i * G + wg; if (L >= nM * 4) return false; int pm, pn; grid_tile(L, nM, 4, pm, pn);
        u.A = Z + (size_t)pm * 256 * (ZC * 2) + ZV * 2; u.B = B + (size_t)pn * 256 * 2048; u.gl = nullptr; u.gvalid = 0; u.mid = 0; u.p0 = pm; u.p1 = pn; u.p2 = 0; u.p3 = 0; return true; } };
struct EpiP5 { static constexpr bool UNIFIED = false, MID_EMPTY = false; float* H; bf16_t* HB; const float* x; const float* meta; int segbase;
    __device__ __forceinline__ void mid(Acc&, const UD&, int, int, int, int) const {}
    __device__ __forceinline__ void operator()(const Acc& acc, const UD& u, int wr, int wc, int fr, int fq) const {
        const int pm = u.p0, pn = u.p1;
#pragma unroll
        for (int ai = 0; ai < 2; ++ai) {
            f32x4 hv[4][2][2]; float* hp[4];
#pragma unroll
            for (int m = 0; m < 4; ++m) { const int row = pm * 256 + OG_ROW; hp[m] = H + (size_t)row * DM + pn * 256 + OG_COL(0);
                const float* rp = hp[m];
                if (x) { int b, p; bp_of(segbase + row, b, p); rp = ((p < NMETA) ? (meta + (size_t)p * DM) : (x + ((size_t)b * SEQ + (p - NMETA)) * DM)) + pn * 256 + OG_COL(0); }
#pragma unroll
                for (int bj = 0; bj < 2; ++bj) { hv[m][bj][0] = *(const f32x4*)(rp + bj * 128); hv[m][bj][1] = *(const f32x4*)(rp + bj * 128 + 4); } }
#pragma unroll
            for (int m = 0; m < 4; ++m)
#pragma unroll
                for (int bj = 0; bj < 2; ++bj) { const f32x4 h0 = hv[m][bj][0] + acc[ai][bj][m][0], h1 = hv[m][bj][1] + acc[ai][bj][m][1]; *(f32x4*)(hp[m] + bj * 128) = h0; *(f32x4*)(hp[m] + bj * 128 + 4) = h1;
                    *(u32x4*)(HB + (hp[m] - H) + bj * 128) = pack8(h0, h1); }
            asm volatile("" ::: "memory"); }
    } };
struct SchedGU { const char* XN; const char* Bgu; const int* LIST; MoeTab mt; int G, wg;
    __device__ __forceinline__ bool get(int i, UD& u) const { const int L = i * G + wg; if (L >= mt.ntiles * 8) return false; const int ct = L >> 3, sel = (L >> 2) & 1, pn = L & 3;
        const int cls = __builtin_amdgcn_readfirstlane(mt.cls[ct]), til = __builtin_amdgcn_readfirstlane(mt.til[ct]), cnt = __builtin_amdgcn_readfirstlane(mt.cntv[cls]); int ea, eb; cls_experts(cls, ea, eb); const int e = sel ? eb : ea;
        u.A = XN; u.B = Bgu + (size_t)e * 2097152 + (size_t)pn * 256 * 2048; u.gl = LIST + (size_t)cls * T + 256 * til; u.gvalid = min(256, cnt - 256 * til); u.mid = 0;
        u.p0 = ct; u.p1 = pn; u.p2 = sel; u.p3 = cls * T + 256 * til; return true; } };
struct EpiGU { static constexpr bool UNIFIED = false, MID_EMPTY = false; bf16_t* HID; const float* WTS;
    __device__ __forceinline__ void mid(Acc&, const UD&, int, int, int, int) const {}
    __device__ __forceinline__ void operator()(const Acc& acc, const UD& u, int wr, int wc, int fr, int fq) const {
        const int ct = u.p0, pn = u.p1, sel = u.p2;
#pragma unroll
        OG_ROWS { const int r = OG_ROW; f32x4 wv4 = (f32x4){0.f, 0.f, 0.f, 0.f}; if (r < u.gvalid) wv4 = *(const f32x4*)(WTS + ((size_t)u.p3 + r) * 4);
            const float rs = wv4[2], wt = (sel ? wv4[1] : wv4[0]) * rs; f32x4 v0, v1;
#pragma unroll
            for (int j = 0; j < 4; ++j) { v0[j] = siluf_(acc[ai][0][m][0][j] * rs) * acc[ai][1][m][0][j] * wt; v1[j] = siluf_(acc[ai][0][m][1][j] * rs) * acc[ai][1][m][1][j] * wt; }
            *(u32x4*)(HID + ((size_t)ct * 256 + r) * 1024 + sel * 512 + pn * 128 + wc * 32 + fq * 8) = pack8(v0, v1); }
    } };
struct SchedDN { const char* HID; const char* Bdn; const int* LIST; MoeTab mt; int G, wg;
    __device__ __forceinline__ bool get(int i, UD& u) const { const int L = (i >> 1) * G + wg; if (L >= mt.ntiles * 4) return false; const int ct = L >> 2, pn = L & 3, part = i & 1;
        const int cls = __builtin_amdgcn_readfirstlane(mt.cls[ct]), til = __builtin_amdgcn_readfirstlane(mt.til[ct]), cnt = __builtin_amdgcn_readfirstlane(mt.cntv[cls]); int ea, eb; cls_experts(cls, ea, eb); const int e = part ? eb : ea;
        u.A = HID + (size_t)ct * 256 * 2048 + part * 1024; u.B = Bdn + (size_t)e * 1048576 + (size_t)pn * 256 * 1024; u.gl = LIST + (size_t)cls * T + 256 * til; u.gvalid = min(256, cnt - 256 * til); u.mid = part ? 0 : 1;
        u.p0 = ct; u.p1 = pn; u.p2 = 0; u.p3 = 0; return true; } };
struct EpiDN { static constexpr bool UNIFIED = false, MID_EMPTY = true; float* H; bf16_t* HB; float* SS; int write_hb;
    __device__ __forceinline__ void mid(Acc&, const UD&, int, int, int, int) const {}
    __device__ __forceinline__ void operator()(const Acc& acc, const UD& u, int wr, int wc, int fr, int fq) const {
        const int pn = u.p1;
        int tok[2][4];
#pragma unroll
        for (int ai = 0; ai < 2; ++ai)
#pragma unroll
            for (int m = 0; m < 4; ++m) { const int r = OG_ROW; tok[ai][m] = (r < u.gvalid) ? u.gl[r] : -1; }
#pragma unroll
        for (int ai = 0; ai < 2; ++ai) {
            f32x4 hv[4][2][2];
#pragma unroll
            for (int m = 0; m < 4; ++m) { const size_t off = (size_t)(tok[ai][m] < 0 ? 0 : tok[ai][m]) * DM + pn * 256 + OG_COL(0);
#pragma unroll
                for (int bj = 0; bj < 2; ++bj) { hv[m][bj][0] = *(const f32x4*)(H + off + bj * 128); hv[m][bj][1] = *(const f32x4*)(H + off + bj * 128 + 4); } }
#pragma unroll
            for (int m = 0; m < 4; ++m) { const bool ok = tok[ai][m] >= 0; const size_t off = (size_t)(ok ? tok[ai][m] : 0) * DM + pn * 256 + OG_COL(0); float sq = 0.f;
#pragma unroll
                for (int bj = 0; bj < 2; ++bj) { const f32x4 h0 = hv[m][bj][0] + acc[ai][bj][m][0], h1 = hv[m][bj][1] + acc[ai][bj][m][1];
                    if (ok) { *(f32x4*)(H + off + bj * 128) = h0; *(f32x4*)(H + off + bj * 128 + 4) = h1; if (write_hb) *(u32x4*)(HB + off + bj * 128) = pack8(h0, h1); }
                    sq += h0[0] * h0[0] + h0[1] * h0[1] + h0[2] * h0[2] + h0[3] * h0[3] + h1[0] * h1[0] + h1[1] * h1[1] + h1[2] * h1[2] + h1[3] * h1[3]; }
                sq += shx<16>(sq); sq = xsum32(sq);
                if (ok && fq == 0) SS[(size_t)tok[ai][m] * 16 + pn * 4 + wc] = sq; }
            asm volatile("" ::: "memory"); }
    } };
}

template <int KIND> __device__ __forceinline__ void tail_phase(const Ctx& c, const LayerW& w, int segbase, int layer);
__device__ __forceinline__ void p1_opt(const Ctx& c, const LayerW& w, int segbase, int segrows) {
    og::SchedP1 S{(const char*)(c.HB + (size_t)segbase * DM), (const char*)w.Bin, segrows / 256, c.G, c.wg}; og::EpiP1 E{c.Z, c.SS + (size_t)segbase * 16, w.b_gate};
    og::gemm_run<og::EpiP1, og::SchedP1, false>(c.lds, S, E, 2048u, 2048u, 16);
}
__device__ __forceinline__ void p4_opt(const Ctx& c, const LayerW& w, int segrows) {
    const bool tail = (segrows / 256 == 65);
    og::SchedP4 S{(const char*)c.Z, (const char*)w.Bbrg, (const char*)w.Bbrp, tail ? 64 : segrows / 256, c.G, c.wg}; og::EpiP4 E{c.Z};
    og::gemm_run<og::EpiP4, og::SchedP4, false>(c.lds, S, E, (unsigned)(ZC * 2), 2048u, 16);
    if (tail) tail_phase<4>(c, w, 0, 0);
}
__device__ __forceinline__ void p5_opt(const Ctx& c, const LayerW& w, int segbase, int segrows, int layer) {
    const bool tail = (segrows / 256 == 65);
    og::SchedP5 S{(const char*)c.Z, (const char*)w.Bout, tail ? 64 : segrows / 256, c.G, c.wg}; og::EpiP5 E{c.H + (size_t)segbase * DM, c.HB + (size_t)segbase * DM, layer == 0 ? inp(c, 0) : nullptr, inp(c, 1), segbase};
    og::gemm_run<og::EpiP5, og::SchedP5, false>(c.lds, S, E, (unsigned)(ZC * 2), 2048u, 16);
    if (tail) tail_phase<5>(c, w, segbase, layer);
}
__device__ __forceinline__ void gu_opt(const Ctx& c, const LayerW& w, int layer) {
    const MoeTab mt = moe_table(c, layer);
    const int vwg = (c.G % 8 == 0) ? (c.wg & 7) * (c.G >> 3) + (c.wg >> 3) : c.wg;
    og::SchedGU S{(const char*)c.HB, (const char*)w.Bgu, (const int*)((const unsigned char*)c.Z + MZ_LIST), mt, c.G, vwg};
    og::EpiGU E{(bf16_t*)((unsigned char*)c.Z + MZ_HID), (const float*)((const unsigned char*)c.Z + MZ_WTS)};
    og::gemm_run<og::EpiGU, og::SchedGU, true>(c.lds, S, E, 2048u, 2048u, 16);
}
__device__ __forceinline__ void dn_opt(const Ctx& c, const LayerW& w, int layer) {
    const MoeTab mt = moe_table(c, layer);
    const int vwg = (c.G % 8 == 0) ? (c.wg & 7) * (c.G >> 3) + (c.wg >> 3) : c.wg;
    og::SchedDN S{(const char*)c.Z + MZ_HID, (const char*)w.Bdn, (const int*)((const unsigned char*)c.Z + MZ_LIST), mt, c.G, vwg};
    og::EpiDN E{c.H, c.HB, c.SS, layer == 0 ? 1 : 0};
    og::gemm_run<og::EpiDN, og::SchedDN, false>(c.lds, S, E, 2048u, 1024u, 8);
}
__device__ __forceinline__ void chunk_rows(int seg, int b, int ch, int& r0, int& nvalid) {
    if (seg == 0) { if (ch == 0) { r0 = b * SEG0_LEN; nvalid = 16; } else { r0 = b * SEG0_LEN + 16 + 64 * (ch - 1); nvalid = 64; } }
    else { r0 = b * SEG1_LEN + 64 * (ch - 17); nvalid = 64; }
}
__device__ __forceinline__ void gla_opt(const Ctx& c, int seg) {
    constexpr int STQ = 272, STT = 144;
    LAS unsigned char* const L = c.lds;
    LAS unsigned char* const QE = L; LAS unsigned char* const QI = L + 17408; LAS unsigned char* const KE = L + 34816; LAS unsigned char* const KI = L + 52224;
    LAS unsigned char* const KDT = L + 69632; LAS unsigned char* const VT = L + 88064; LAS unsigned char* const ATT = L + 97280;
    LAS float* const PART = (LAS float*)(L + 106496); LAS float* const EG = (LAS float*)(L + 110592); LAS unsigned char* const OP = L + 111104;
    const int lane = c.lane, w = c.wave, fr = lane & 15, g = lane >> 4, vt = w & 3, chh = w >> 2;
    const float LOG2E = 1.4426950408889634f;
    float* stsave = (float*)(c.ws + WS_STATE);
    for (int cw = c.wg; cw < 256; cw += c.G) {
        const int chain = (cw & 7) * 32 + (cw >> 3);
        const int b = chain >> 4, h = (chain >> 2) & 3, s = chain & 3;
        f32x4 S0, S1, S2, S3;
        if (seg == 0) { S0 = (f32x4){0.f, 0.f, 0.f, 0.f}; S1 = S0; S2 = S0; S3 = S0; }
        else { const f32x4* sp = (const f32x4*)(stsave + ((size_t)chain * 512 + c.tid) * 16); S0 = sp[0]; S1 = sp[1]; S2 = sp[2]; S3 = sp[3]; }
        const int c_lo = seg == 0 ? 0 : 17, c_hi = seg == 0 ? 17 : 33;
        unsigned q2[8], k2[8], g2[8]; u32x4 vraw;
#define GLA_LOAD(chk) do { int r0_, nv_; chunk_rows(seg, b, (chk), r0_, nv_); const char* zb_ = (const char*)c.Z + (size_t)r0_ * (ZC * 2); \
        _Pragma("unroll") for (int i = 0; i < 8; ++i) { const int row_ = 8 * w + i; const bool ok_ = row_ < nv_; const char* p_ = zb_ + (size_t)(ok_ ? row_ : 0) * (ZC * 2);     \
            const unsigned a_ = *(const unsigned*)(p_ + ZQ * 2 + loff), b_ = *(const unsigned*)(p_ + ZK * 2 + loff), c_ = *(const unsigned*)(p_ + ZG * 2 + loff); \
            q2[i] = a_; k2[i] = b_; g2[i] = c_; } \
        { const bool okv_ = lane < nv_; const u32x4 v_ = *(const u32x4*)(zb_ + (size_t)((okv_ ? (unsigned)lane : 0u) * (unsigned)(ZC * 2) + voff)); \
          vraw = v_; } } while (0)
        const unsigned loff = (unsigned)(h * 128 + 2 * lane) * 2u, voff = (unsigned)(ZV + h * 256 + s * 64 + 8 * w) * 2u;
        GLA_LOAD(c_lo);
        for (int chk = c_lo; chk < c_hi; ++chk) {
            int r0, nvalid; chunk_rows(seg, b, chk, r0, nvalid);
            if (nvalid < 64) {
#pragma unroll
                for (int i = 0; i < 8; ++i) { const bool ok = 8 * w + i < nvalid; q2[i] = ok ? q2[i] : 0u; k2[i] = ok ? k2[i] : 0u; g2[i] = ok ? g2[i] : 0u; }
                if (lane >= nvalid) vraw = (u32x4){0u, 0u, 0u, 0u}; }
            float cl0[8], cl1[8]; { float a0 = 0.f, a1 = 0.f;
#pragma unroll
                for (int i = 0; i < 8; ++i) { a0 += bflo(g2[i]); a1 += bfhi(g2[i]); cl0[i] = a0; cl1[i] = a1; }
                *(LAS f32x2*)(PART + w * 128 + 2 * lane) = (f32x2){a0, a1}; }
            __syncthreads();
            float p0 = 0.f, p1 = 0.f, t0 = 0.f, t1 = 0.f;
#pragma unroll
            for (int r = 0; r < 8; ++r) { const f32x2 x = *(const LAS f32x2*)(PART + r * 128 + 2 * lane); t0 += x[0]; t1 += x[1]; if (r < w) { p0 += x[0]; p1 += x[1]; } }
            const float eg0 = __builtin_amdgcn_exp2f(t0 * LOG2E), eg1 = __builtin_amdgcn_exp2f(t1 * LOG2E);
            if (w == 0) *(LAS f32x2*)(EG + 2 * lane) = (f32x2){eg0, eg1};
            unsigned kd0[4], kd1[4]; float dprev0 = 0.f, dprev1 = 0.f;
#pragma unroll
            for (int i = 0; i < 8; ++i) {
                const float b0 = (p0 + cl0[i]) * LOG2E, b1 = (p1 + cl1[i]) * LOG2E;
                const float e0 = __builtin_amdgcn_exp2f(b0), e1 = __builtin_amdgcn_exp2f(b1), ie0 = __builtin_amdgcn_exp2f(-b0), ie1 = __builtin_amdgcn_exp2f(-b1);
                const float qa = bflo(q2[i]), qb = bfhi(q2[i]), ka = bflo(k2[i]), kb = bfhi(k2[i]);
                const int ro = (8 * w + i) * STQ + 4 * lane;
                *(LAS unsigned*)(QE + ro) = og::cvt_pk_bf16(qa * e0, qb * e1); *(LAS unsigned*)(QI + ro) = og::cvt_pk_bf16(qa * ie0, qb * ie1);
                *(LAS unsigned*)(KE + ro) = og::cvt_pk_bf16(ka * e0, kb * e1); *(LAS unsigned*)(KI + ro) = og::cvt_pk_bf16(ka * ie0, kb * ie1);
                const float d0 = ka * ie0 * eg0, d1 = kb * ie1 * eg1;
                if (i & 1) { kd0[i >> 1] = og::cvt_pk_bf16(dprev0, d0); kd1[i >> 1] = og::cvt_pk_bf16(dprev1, d1); } else { dprev0 = d0; dprev1 = d1; }
            }
            *(LAS u32x4*)(KDT + (2 * lane) * STT + w * 16) = (u32x4){kd0[0], kd0[1], kd0[2], kd0[3]};
            *(LAS u32x4*)(KDT + (2 * lane + 1) * STT + w * 16) = (u32x4){kd1[0], kd1[1], kd1[2], kd1[3]};
#pragma unroll
            for (int j = 0; j < 4; ++j) { *(LAS bf16_t*)(VT + (8 * w + 2 * j) * STT + 2 * lane) = (bf16_t)(vraw[j] & 0xffffu); *(LAS bf16_t*)(VT + (8 * w + 2 * j + 1) * STT + 2 * lane) = (bf16_t)(vraw[j] >> 16); }
            if (chk + 1 < c_hi) { GLA_LOAD(chk + 1); }
            __syncthreads();
            { const int it = w >> 1;
#pragma unroll
              for (int tj = 0; tj < 2; ++tj) { const int jt = 2 * (w & 1) + tj;
                f32x4 lo = (f32x4){0.f, 0.f, 0.f, 0.f}, up = lo;
                if (it >= jt) {
#pragma unroll
                    for (int kb = 0; kb < 4; ++kb) { const bf16x8 a = *(const LAS bf16x8*)(QE + (16 * it + fr) * STQ + (32 * kb + 8 * g) * 2), bb = *(const LAS bf16x8*)(KI + (16 * jt + fr) * STQ + (32 * kb + 8 * g) * 2);
                        lo = __builtin_amdgcn_mfma_f32_16x16x32_bf16(a, bb, lo, 0, 0, 0); } }
                if (it <= jt) {
#pragma unroll
                    for (int kb = 0; kb < 4; ++kb) { const bf16x8 a = *(const LAS bf16x8*)(QI + (16 * it + fr) * STQ + (32 * kb + 8 * g) * 2), bb = *(const LAS bf16x8*)(KE + (16 * jt + fr) * STQ + (32 * kb + 8 * g) * 2);
                        up = __builtin_amdgcn_mfma_f32_16x16x32_bf16(a, bb, up, 0, 0, 0); } }
#pragma unroll
                for (int r = 0; r < 4; ++r) { const int il = 4 * g + r; float v = (it > jt) ? lo[r] : (it < jt) ? up[r] : ((il >= fr) ? lo[r] : up[r]);
                    *(LAS bf16_t*)(ATT + (16 * it + il) * STT + (16 * jt + fr) * 2) = (bf16_t)og::cvt_pk_bf16(v, v); } } }
            f32x4 o0 = (f32x4){0.f, 0.f, 0.f, 0.f}, o1 = o0, o2 = o0, o3 = o0;
#pragma unroll
            for (int kbl = 0; kbl < 2; ++kbl) {
                const f32x4 sa = kbl ? S2 : S0, sb = kbl ? S3 : S1;
                const u32x4 bw = (u32x4){og::cvt_pk_bf16(sa[0], sa[1]), og::cvt_pk_bf16(sa[2], sa[3]), og::cvt_pk_bf16(sb[0], sb[1]), og::cvt_pk_bf16(sb[2], sb[3])};
                bf16x8 bfr; __builtin_memcpy(&bfr, &bw, 16);
                const int cb = (64 * chh + 32 * kbl + 4 * g) * 2;
#define GLA_OI(oacc, itv) do { const u32x2 x0 = *(const LAS u32x2*)(QE + (16 * (itv) + fr) * STQ + cb), x1 = *(const LAS u32x2*)(QE + (16 * (itv) + fr) * STQ + cb + 32); \
                    const u32x4 aw = (u32x4){x0.x, x0.y, x1.x, x1.y}; bf16x8 af; __builtin_memcpy(&af, &aw, 16); oacc = __builtin_amdgcn_mfma_f32_16x16x32_bf16(af, bfr, oacc, 0, 0, 0); } while (0)
                GLA_OI(o0, 0); GLA_OI(o1, 1); GLA_OI(o2, 2); GLA_OI(o3, 3);
            }
#define GLA_SU(Sx, ct) do { const f32x4 ev = *(const LAS f32x4*)(EG + 64 * chh + 16 * (ct) + 4 * g); Sx = Sx * ev; \
                _Pragma("unroll") for (int kb = 0; kb < 2; ++kb) { const bf16x8 a = *(const LAS bf16x8*)(KDT + (64 * chh + 16 * (ct) + fr) * STT + (32 * kb + 8 * g) * 2), bb = *(const LAS bf16x8*)(VT + (16 * vt + fr) * STT + (32 * kb + 8 * g) * 2); \
                    Sx = __builtin_amdgcn_mfma_f32_16x16x32_bf16(a, bb, Sx, 0, 0, 0); } } while (0)
            GLA_SU(S0, 0); GLA_SU(S1, 1); GLA_SU(S2, 2); GLA_SU(S3, 3);
            __syncthreads();
#define GLA_OA(oacc, itv) do { const bf16x8 a = *(const LAS bf16x8*)(ATT + (16 * (itv) + fr) * STT + (32 * chh + 8 * g) * 2), bb = *(const LAS bf16x8*)(VT + (16 * vt + fr) * STT + (32 * chh + 8 * g) * 2); \
                oacc = __builtin_amdgcn_mfma_f32_16x16x32_bf16(a, bb, oacc, 0, 0, 0); } while (0)
            GLA_OA(o0, 0); GLA_OA(o1, 1); GLA_OA(o2, 2); GLA_OA(o3, 3);
            f32x4 m0, m1, x0, x1;
            if (chh) { m0 = o2; m1 = o3; x0 = o0; x1 = o1; } else { m0 = o0; m1 = o1; x0 = o2; x1 = o3; }
            *(LAS f32x4*)(OP + ((vt * 2 + chh) * 2 + 0) * 1024 + lane * 16) = x0; *(LAS f32x4*)(OP + ((vt * 2 + chh) * 2 + 1) * 1024 + lane * 16) = x1;
            __syncthreads();
            m0 += *(const LAS f32x4*)(OP + ((vt * 2 + (1 - chh)) * 2 + 0) * 1024 + lane * 16); m1 += *(const LAS f32x4*)(OP + ((vt * 2 + (1 - chh)) * 2 + 1) * 1024 + lane * 16);
            { char* ob = (char*)c.Z + (size_t)r0 * (ZC * 2); const unsigned oo = (unsigned)(ZV + h * 256 + s * 64 + 16 * vt + fr) * 2u + (unsigned)(32 * chh + 4 * g) * (unsigned)(ZC * 2);
              if (nvalid == 64) {
#pragma unroll
                for (int r = 0; r < 4; ++r) { *(bf16_t*)(ob + (size_t)(oo + (unsigned)r * (ZC * 2))) = (bf16_t)og::cvt_pk_bf16(m0[r], m0[r]); *(bf16_t*)(ob + (size_t)(oo + (unsigned)(16 + r) * (ZC * 2))) = (bf16_t)og::cvt_pk_bf16(m1[r], m1[r]); }
              } else {
#pragma unroll
                for (int r = 0; r < 4; ++r) { const int i0 = 32 * chh + 4 * g + r, i1 = i0 + 16;
                    if (i0 < nvalid) *(bf16_t*)(ob + (size_t)(oo + (unsigned)r * (ZC * 2))) = (bf16_t)og::cvt_pk_bf16(m0[r], m0[r]);
                    if (i1 < nvalid) *(bf16_t*)(ob + (size_t)(oo + (unsigned)(16 + r) * (ZC * 2))) = (bf16_t)og::cvt_pk_bf16(m1[r], m1[r]); } } }
        }
        if (seg == 0) { f32x4* sp = (f32x4*)(stsave + ((size_t)chain * 512 + c.tid) * 16); sp[0] = S0; sp[1] = S1; sp[2] = S2; sp[3] = S3; }
        __syncthreads();
#undef GLA_LOAD
#undef GLA_OI
#undef GLA_SU
#undef GLA_OA
    }
}
template <int KIND>
__device__ __forceinline__ void tail_phase(const Ctx& c, const LayerW& w, int segbase, int layer) {
    constexpr int TR0 = 16384;
    LAS float* RED = (LAS float*)c.lds;
    const int lane = c.lane;
    for (int st = c.wg; st < 256; st += c.G) {
        const int m0 = TR0 + (st >> 4) * 16, n0 = (st & 15) * 64;
        f32x4 a1[4], a2[4]; ZERO_ACC(a1); ZERO_ACC(a2);
        if (KIND == 4) { const int kb = c.wave * 128;
            sg_acc_n<4>(a1, c.Z + (size_t)(m0 + (lane & 15)) * ZC + ZOG + kb, w.Bbrg + kb, DM, n0, lane);
            sg_acc_n<4>(a2, c.Z + (size_t)(m0 + (lane & 15)) * ZC + ZQ + kb, w.Bbrp + kb, DM, n0, lane); }
        if (KIND == 5) { const int kb = c.wave * 128;
            sg_acc_n<4>(a1, c.Z + (size_t)(m0 + (lane & 15)) * ZC + ZV + kb, w.Bout + kb, DM, n0, lane); }
        __syncthreads();
#pragma unroll
        for (int j = 0; j < 4; ++j) { *(LAS f32x4*)(RED + (((c.wave * 2 + 0) * 4 + j) * 64 + lane) * 4) = a1[j]; if (KIND == 4) *(LAS f32x4*)(RED + (((c.wave * 2 + 1) * 4 + j) * 64 + lane) * 4) = a2[j]; }
        __syncthreads();
        for (int e = c.tid; e < 1024; e += 512) { const int r = e >> 6, col = e & 63, j = col >> 4, ln = (col & 15) + 16 * (r >> 2), reg = r & 3;
            float s1 = 0.f, s2 = 0.f;
#pragma unroll
            for (int wv = 0; wv < 8; ++wv) { s1 += RED[(((wv * 2 + 0) * 4 + j) * 64 + ln) * 4 + reg]; if (KIND == 4) s2 += RED[(((wv * 2 + 1) * 4 + j) * 64 + ln) * 4 + reg]; }
            const int m = m0 + r, n = n0 + col;
            if (KIND == 4) { bf16_t* zr = c.Z + (size_t)m * ZC; zr[ZV + n] = f2bf(bf2f(zr[ZG0 + n]) * s1 + bf2f(zr[ZG1 + n]) * s2); }
            if (KIND == 5) { float res; if (layer == 0) { int b, p; bp_of(segbase + m, b, p); res = (p < NMETA) ? inp(c, 1)[(size_t)p * DM + n] : inp(c, 0)[((size_t)b * SEQ + (p - NMETA)) * DM + n]; } else res = c.H[(size_t)(segbase + m) * DM + n];
                const float hv = res + s1; c.H[(size_t)(segbase + m) * DM + n] = hv; c.HB[(size_t)(segbase + m) * DM + n] = f2bf(hv); } }
    }
    __syncthreads();
}
constexpr int N_PHASES = 28;
struct Params { const float* in[19]; float* out; unsigned char* ws; int ph_lo, ph_hi; };
#ifndef ONE_LAUNCH
#define ONE_LAUNCH 1
#endif
__global__ void __launch_bounds__(512, 2) k_fwd(Params p) {
    extern __shared__ __attribute__((aligned(16))) unsigned char lds_raw[];
    Ctx c;
    c.out = p.out; c.ws = p.ws; c.lds = (LAS unsigned char*)lds_raw;
    c.tid = threadIdx.x; c.lane = c.tid & 63; c.wave = __builtin_amdgcn_readfirstlane(c.tid >> 6); c.G = gridDim.x; c.wg = blockIdx.x;
    c.ctl = (unsigned*)(p.ws + WS_CTL); c.H = (float*)(p.ws + WS_H); c.HB = (bf16_t*)(p.ws + WS_HB); c.SS = (float*)(p.ws + WS_SS); c.Z = (bf16_t*)(p.ws + WS_Z);
    volatile LAS unsigned* misc = (volatile LAS unsigned*)(c.lds + MISC_OFF);
    if (c.tid < 16) misc[c.tid] = 0u;
    if (c.tid == 0) {
#pragma unroll
        for (int k = 0; k < 19; ++k) { const unsigned long long a = (unsigned long long)p.in[k]; misc[16 + 2 * k] = (unsigned)a; misc[16 + 2 * k + 1] = (unsigned)(a >> 32); } }
    __syncthreads();
    const int lo = p.ph_lo, hi = p.ph_hi;
    if (hi - lo > 1) (void)xcd_barrier_post(c.ctl + CW_BAR, misc);
#define FRESH() do { w = layer_w(c, l); int t_ = threadIdx.x; asm volatile("" : "+v"(t_)); c.tid = t_; c.lane = t_ & 63; c.wave = __builtin_amdgcn_readfirstlane(t_ >> 6); int g_ = blockIdx.x; asm volatile("" : "+s"(g_)); c.wg = g_; } while (0)
#ifdef PROBE_MASK
    unsigned long long pr_acc = 0ull, pr_t0 = 0ull;
#ifdef PROBE_EPI
#define PR_BEGIN(kind) do { if ((PROBE_MASK >> (kind)) & 1) { if (threadIdx.x == 0) ((volatile LAS unsigned long long*)(c.lds + MISC_OFF + 32))[1] = 1ull; __syncthreads(); } } while (0)
#define PR_END(kind) do { if ((PROBE_MASK >> (kind)) & 1) { __syncthreads(); if (threadIdx.x == 0) ((volatile LAS unsigned long long*)(c.lds + MISC_OFF + 32))[1] = 0ull; __syncthreads(); } } while (0)
#else
#define PR_BEGIN(kind) do { if ((PROBE_MASK >> (kind)) & 1) pr_t0 = wall_clock64(); } while (0)
#define PR_END(kind) do { if ((PROBE_MASK >> (kind)) & 1) pr_acc += wall_clock64() - pr_t0; } while (0)
#endif
#else
#define PR_BEGIN(kind) do { } while (0)
#define PR_END(kind) do { } while (0)
#endif
#define IN(k) (lo <= (k) && (k) < hi)
#define SEAM(k) do { if (IN(k) && IN((k) + 1)) { XcdBarrier b2; b2.bar = (unsigned*)(c.ws + WS_CTL) + CW_BAR; b2.x = xb_xcc_id(); b2.st = (volatile LAS unsigned*)(c.lds + MISC_OFF); xcd_barrier(b2); } } while (0)
    LayerW w; int l = 0;
    PR_BEGIN(0); if (IN(0)) { FRESH(); phase_prep(c); }
    SEAM(0); PR_END(0);
    for (l = 0; l < 2; ++l) {
        const int base = 1 + 13 * l;
        for (int s = 0; s < 2; ++s) {
            const int sb = base + 5 * s, segbase = s ? SEG0_ROWS : 0, segrows = s ? SEG1_ROWS : SEG0_ROWS;
            PR_BEGIN(1); if (IN(sb + 0)) { FRESH(); P1_IMPL(c, w, segbase, segrows); }
            SEAM(sb + 0); PR_END(1);
            PR_BEGIN(2); if (IN(sb + 1)) { FRESH(); P2_IMPL(c, s); }
            SEAM(sb + 1); PR_END(2);
            PR_BEGIN(3); if (IN(sb + 2)) { FRESH(); pool_phase(c, s); FRESH(); ygla_phase(c, w, segrows); }
            SEAM(sb + 2); PR_END(3);
            PR_BEGIN(4); if (IN(sb + 3)) { FRESH(); P4_IMPL(c, w, segrows); }
            SEAM(sb + 3); PR_END(4);
            PR_BEGIN(5); if (IN(sb + 4)) { FRESH(); P5_IMPL(c, w, segbase, segrows, l); }
            SEAM(sb + 4); PR_END(5);
        }
        PR_BEGIN(6); if (IN(base + 10)) { FRESH(); route_phase(c, w, l); }
        SEAM(base + 10); PR_END(6);
        PR_BEGIN(7); if (IN(base + 11)) { FRESH(); GU_IMPL(c, w, l); }
        SEAM(base + 11); PR_END(7);
        PR_BEGIN(8); if (IN(base + 12)) { FRESH(); DN_IMPL(c, w, l); }
        SEAM(base + 12); PR_END(8);
    }
    l = 1;
    PR_BEGIN(9); if (IN(27)) { FRESH(); final_phase(c); } PR_END(9);
#ifdef PROBE_MASK
#ifdef PROBE_EPI
    __syncthreads(); pr_acc = ((volatile LAS unsigned long long*)(c.lds + MISC_OFF + 32))[0];
#endif
    if (blockIdx.x == 0) { const unsigned long long tend = wall_clock64() + (unsigned long long)PROBE_F * pr_acc; while (wall_clock64() < tend) __builtin_amdgcn_s_sleep(8); }
#endif
#undef IN
#undef SEAM
}

extern "C" void kernel_launch(void* const* d_in, const int* in_sizes, int n_in, void* d_out, int out_size, void* d_ws, size_t ws_size, hipStream_t stream) {
    static int grid = 0;
    if (grid == 0) {
        if (n_in != 19 || out_size != NB * SEQ * DM || ws_size < WS_END) { fprintf(stderr, "kernel_launch: unexpected shapes (n_in %d out %d ws %zu need %zu)\n", n_in, out_size, ws_size, (size_t)WS_END); grid = -1; return; }
        int dev = 0, cus = 0, per_cu = 0;
        if (hipGetDevice(&dev) != hipSuccess || hipDeviceGetAttribute(&cus, hipDeviceAttributeMultiprocessorCount, dev) != hipSuccess) { grid = -1; return; }
        if (hipFuncSetAttribute((const void*)k_fwd, hipFuncAttributeMaxDynamicSharedMemorySize, LDS_BYTES) != hipSuccess) { fprintf(stderr, "kernel_launch: hipFuncSetAttribute failed\n"); grid = -1; return; }
        if (hipOccupancyMaxActiveBlocksPerMultiprocessor(&per_cu, (const void*)k_fwd, 512, LDS_BYTES) != hipSuccess || per_cu < 1) fprintf(stderr, "kernel_launch: occupancy query says %d\n", per_cu);
        (void)hipGetLastError();
        grid = cus;
        if (grid < 65) { fprintf(stderr, "kernel_launch: %d CUs: the router's per-wave record table is sized for 65+ workgroups\n", grid); grid = -1; return; }
    }
    if (grid < 0) return;
    if (hipMemsetAsync((char*)d_ws + WS_CTL, 0, CTL_BYTES, stream) != hipSuccess) return;
    Params p{};
    for (int i = 0; i < 19; ++i) p.in[i] = (const float*)d_in[i];
    p.out = (float*)d_out; p.ws = (unsigned char*)d_ws;
#if ONE_LAUNCH
    p.ph_lo = 0; p.ph_hi = N_PHASES;
    hipLaunchKernelGGL(k_fwd, dim3(grid), dim3(512), LDS_BYTES, stream, p);
#else
    for (int k = 0; k < N_PHASES; ++k) { p.ph_lo = k; p.ph_hi = k + 1; hipLaunchKernelGGL(k_fwd, dim3(grid), dim3(512), LDS_BYTES, stream, p); }
#endif
}
```
